# Optimizing an MI355X kernel written in HIP

```python
import jax, jax.numpy as jnp
from jax import lax
import numpy as np

D_MODEL = 1024
BATCH = 8
SEQ = 2048
DEPTH = 2

GRID_W = 64
CTX_LEN = 256
D_MIX = D_MODEL
HEAD_DIM = 64
ATT_W = D_MIX // 2
N_HEADS = ATT_W // HEAD_DIM
N_KV_HEADS = 2
GQA_GROUP = N_HEADS // N_KV_HEADS
KV_W = N_KV_HEADS * HEAD_DIM
CONV_W = D_MIX // 4
FOUR_W = D_MIX - ATT_W - CONV_W
FOUR_HEADS = 4
FOUR_HEAD_DIM = FOUR_W // FOUR_HEADS
CONV_K = 31
WINDOW = 128
BLOCK = 128
ROPE_BASE = 10000.0
EPS = 1e-6
NEG_INF = -1e30
SPLITS = (ATT_W, KV_W, KV_W, ATT_W, CONV_W, CONV_W, CONV_W, FOUR_W, FOUR_W)
IN_W = ATT_W + 2 * KV_W + ATT_W + 3 * CONV_W + 2 * FOUR_W

kernel_name = 'hybrid_conv_fourier_swa_diffusion_block'


def rms_norm(x, g):
    xf = x.astype(jnp.float32)
    y = xf * lax.rsqrt(jnp.mean(xf * xf, axis=-1, keepdims=True) + EPS)
    return (y * g.astype(jnp.float32)).astype(x.dtype)


def layer_norm(x, g, b):
    xf = x.astype(jnp.float32)
    mu = jnp.mean(xf, axis=-1, keepdims=True)
    var = jnp.mean(jnp.square(xf - mu), axis=-1, keepdims=True)
    y = (xf - mu) * lax.rsqrt(var + EPS)
    return (y * g.astype(jnp.float32) + b.astype(jnp.float32)).astype(x.dtype)


def split_cols(p):
    outs = []
    off = 0
    for w in SPLITS:
        outs.append(p[..., off:off + w])
        off += w
    return outs


def rope_axis(x, pos):
    half = x.shape[-1] // 2
    freqs = ROPE_BASE ** (-jnp.arange(half, dtype=jnp.float32) / half)
    ang = pos[:, None] * freqs[None, :]
    cos = jnp.cos(ang)[:, None, :].astype(x.dtype)
    sin = jnp.sin(ang)[:, None, :].astype(x.dtype)
    x1, x2 = x[..., :half], x[..., half:]
    return jnp.concatenate([x1 * cos - x2 * sin, x1 * sin + x2 * cos], axis=-1)


def rope_2d(x, row, col):
    h = x.shape[-1] // 2
    return jnp.concatenate([rope_axis(x[..., :h], row), rope_axis(x[..., h:], col)], axis=-1)


def windowed_attention(q, k, v, kc, vc, sink):
    bn, s = q.shape[0], q.shape[1]
    nb = s // BLOCK
    n_ctx = kc.shape[1]
    scale = HEAD_DIM ** -0.5
    qb = q.reshape(bn, nb, BLOCK, N_KV_HEADS, GQA_GROUP, HEAD_DIM)
    pad = ((0, 0), (BLOCK, BLOCK), (0, 0), (0, 0))
    kp = jnp.pad(k, pad).reshape(bn, nb + 2, BLOCK, N_KV_HEADS, HEAD_DIM)
    vp = jnp.pad(v, pad).reshape(bn, nb + 2, BLOCK, N_KV_HEADS, HEAD_DIM)
    kw = jnp.concatenate([kp[:, :-2], kp[:, 1:-1], kp[:, 2:]], axis=2)
    vw = jnp.concatenate([vp[:, :-2], vp[:, 1:-1], vp[:, 2:]], axis=2)
    s_loc = jnp.einsum('bnqhgd,bnkhd->bnhgqk', qb, kw).astype(jnp.float32) * scale
    q_rel = jnp.arange(BLOCK) + BLOCK
    k_rel = jnp.arange(3 * BLOCK)
    band = jnp.abs(q_rel[:, None] - k_rel[None, :]) <= WINDOW
    k_abs = jnp.arange(nb)[:, None] * BLOCK - BLOCK + k_rel[None, :]
    valid = (k_abs >= 0) & (k_abs < s)
    mask = band[None, :, :] & valid[:, None, :]
    s_loc = jnp.where(mask[None, :, None, None], s_loc, NEG_INF)
    s_ctx = jnp.einsum('bnqhgd,blhd->bnhgql', qb, kc).astype(jnp.float32) * scale
    s_sink = jnp.broadcast_to(
        sink.astype(jnp.float32).reshape(1, 1, N_KV_HEADS, GQA_GROUP, 1, 1),
        s_loc.shape[:-1] + (1,))
    p = jax.nn.softmax(jnp.concatenate([s_loc, s_ctx, s_sink], axis=-1), axis=-1)
    p_loc = p[..., :3 * BLOCK].astype(v.dtype)
    p_ctx = p[..., 3 * BLOCK:3 * BLOCK + n_ctx].astype(v.dtype)
    o = (jnp.einsum('bnhgqk,bnkhd->bnqhgd', p_loc, vw)
         + jnp.einsum('bnhgql,blhd->bnqhgd', p_ctx, vc))
    return o.reshape(bn, s, ATT_W)


def context_attention(q, k, v, sink):
    bn, n_ctx = q.shape[0], q.shape[1]
    scale = HEAD_DIM ** -0.5
    qh = q.reshape(bn, n_ctx, N_KV_HEADS, GQA_GROUP, HEAD_DIM)
    sc = jnp.einsum('blhgd,bmhd->bhglm', qh, k).astype(jnp.float32) * scale
    s_sink = jnp.broadcast_to(
        sink.astype(jnp.float32).reshape(1, N_KV_HEADS, GQA_GROUP, 1, 1), sc.shape[:-1] + (1,))
    p = jax.nn.softmax(jnp.concatenate([sc, s_sink], axis=-1), axis=-1)
    o = jnp.einsum('bhglm,bmhd->blhgd', p[..., :n_ctx].astype(v.dtype), v)
    return o.reshape(bn, n_ctx, ATT_W)


def conformer_conv(a, b_glu, conv_w, conv_b, ln_g, ln_b):
    u = a * jax.nn.sigmoid(b_glu)
    y = lax.conv_general_dilated(
        u, conv_w[:, None, :], window_strides=(1,),
        padding=[(CONV_K // 2, CONV_K // 2)],
        dimension_numbers=('NWC', 'WIO', 'NWC'),
        feature_group_count=CONV_W) + conv_b
    return jax.nn.silu(layer_norm(y, ln_g, ln_b))


def fourier_mix(u, w_four, b_four):
    bn, n = u.shape[0], u.shape[1]
    uh = u.reshape(bn, n, FOUR_HEADS, FOUR_HEAD_DIM).astype(jnp.float32)
    f = jnp.fft.fftn(uh, axes=(1, 3), norm='ortho').real
    f = f.reshape(bn, n, FOUR_W).astype(u.dtype)
    return f @ w_four + b_four


def mixer_out(attn, parts, conv_w, conv_b, ln_g, ln_b, w_four, b_four, w_out):
    _, _, _, g_att, c_a, c_b, g_conv, f_u, g_four = parts
    y_conv = conformer_conv(c_a, c_b, conv_w, conv_b, ln_g, ln_b)
    y_four = fourier_mix(f_u, w_four, b_four)
    y = jnp.concatenate([attn * jax.nn.silu(g_att),
                         y_conv * jax.nn.silu(g_conv),
                         y_four * jax.nn.silu(g_four)], axis=-1)
    return y @ w_out


def setup_inputs(seed: int = 0) -> dict:
    key = jax.random.key(seed)
    ks = jax.random.split(key, 20)
    f32 = jnp.float32
    nrm = lambda k, shp, s: jax.random.normal(k, shp, f32) * s
    return {
        'x': nrm(ks[0], (BATCH, SEQ, D_MODEL), 1.0),
        'c': nrm(ks[1], (BATCH, D_MODEL), 1.0),
        'ctx': nrm(ks[2], (BATCH, CTX_LEN, D_MODEL), 1.0),
        'c_ctx': nrm(ks[3], (D_MODEL,), 1.0),
        'w_ada': nrm(ks[4], (DEPTH, D_MODEL, 3 * D_MODEL), 0.5 * D_MODEL ** -0.5),
        'b_ada': nrm(ks[5], (DEPTH, 3 * D_MODEL), 0.02),
        'norm_g': 1.0 + nrm(ks[6], (DEPTH, D_MODEL), 0.02),
        'w_in': nrm(ks[7], (DEPTH, D_MODEL, IN_W), D_MODEL ** -0.5),
        'attn_sink': nrm(ks[8], (DEPTH, N_HEADS), 0.5),
        'conv_w': nrm(ks[9], (DEPTH, CONV_K, CONV_W), CONV_K ** -0.5),
        'conv_b': nrm(ks[10], (DEPTH, CONV_W), 0.02),
        'conv_ln_g': 1.0 + nrm(ks[11], (DEPTH, CONV_W), 0.02),
        'conv_ln_b': nrm(ks[12], (DEPTH, CONV_W), 0.02),
        'w_four': nrm(ks[13], (DEPTH, FOUR_W, FOUR_W), FOUR_W ** -0.5),
        'b_four': nrm(ks[14], (DEPTH, FOUR_W), 0.02),
        'w_out': nrm(ks[15], (DEPTH, D_MIX, D_MODEL), D_MIX ** -0.5),
        'final_g': 1.0 + nrm(ks[16], (D_MODEL,), 0.02),
    }


def reference(x, c, ctx, c_ctx, w_ada, b_ada, norm_g, w_in, attn_sink, conv_w, conv_b,
              conv_ln_g, conv_ln_b, w_four, b_four, w_out, final_g):
    bn, s, _ = x.shape
    n_ctx = ctx.shape[1]
    ROWS = s // GRID_W
    row_pos = jnp.repeat(jnp.arange(ROWS, dtype=jnp.float32), GRID_W)
    col_pos = jnp.tile(jnp.arange(GRID_W, dtype=jnp.float32), ROWS)
    sc = jax.nn.silu(c)
    scc = jax.nn.silu(c_ctx)
    h_ctx = ctx
    for l in range(DEPTH):
        shift, scale, gate = jnp.split(sc @ w_ada[l] + b_ada[l], 3, axis=-1)
        shift_c, scale_c, gate_c = jnp.split(scc @ w_ada[l] + b_ada[l], 3, axis=-1)
        hc = rms_norm(h_ctx, norm_g[l]) * (1.0 + scale_c) + shift_c
        if l < DEPTH - 1:
            pc = split_cols(hc @ w_in[l])
            kc_raw, vc_raw = pc[1], pc[2]
        else:
            kv = hc @ w_in[l][:, ATT_W:ATT_W + 2 * KV_W]
            kc_raw, vc_raw = kv[..., :KV_W], kv[..., KV_W:]
        kc = kc_raw.reshape(bn, n_ctx, N_KV_HEADS, HEAD_DIM)
        vc = vc_raw.reshape(bn, n_ctx, N_KV_HEADS, HEAD_DIM)

        hx = rms_norm(x, norm_g[l]) * (1.0 + scale[:, None, :]) + shift[:, None, :]
        px = split_cols(hx @ w_in[l])
        q = rope_2d(px[0].reshape(bn, s, N_HEADS, HEAD_DIM), row_pos, col_pos)
        k = rope_2d(px[1].reshape(bn, s, N_KV_HEADS, HEAD_DIM), row_pos, col_pos)
        v = px[2].reshape(bn, s, N_KV_HEADS, HEAD_DIM)
        attn = windowed_attention(q, k, v, kc, vc, attn_sink[l])
        y = mixer_out(attn, px, conv_w[l], conv_b[l], conv_ln_g[l], conv_ln_b[l],
                      w_four[l], b_four[l], w_out[l])

        if l < DEPTH - 1:
            qc = pc[0].reshape(bn, n_ctx, N_HEADS, HEAD_DIM)
            attn_c = context_attention(qc, kc, vc, attn_sink[l])
            yc = mixer_out(attn_c, pc, conv_w[l], conv_b[l], conv_ln_g[l], conv_ln_b[l],
                           w_four[l], b_four[l], w_out[l])
            h_ctx = h_ctx + gate_c * yc
        x = x + gate[:, None, :] * y
    return rms_norm(x, final_g)
```

```cpp
#include <hip/hip_runtime.h>
#include <hip/hip_cooperative_groups.h>
#include <cstdio>
#include <cstdint>
namespace cg = cooperative_groups;

#ifndef MK_MULTI
#define MK_MULTI 0
#endif

typedef unsigned short bf16_t;
typedef short bf16x8 __attribute__((ext_vector_type(8)));
typedef short bf16x4 __attribute__((ext_vector_type(4)));
typedef float f32x4 __attribute__((ext_vector_type(4)));
typedef float f32x16 __attribute__((ext_vector_type(16)));
typedef unsigned u32x4 __attribute__((ext_vector_type(4)));
typedef unsigned u32x2 __attribute__((ext_vector_type(2)));
#define DEV __device__ __forceinline__

constexpr int NTOK = 16384, NCTXT = 2048, MTOT = 18432, DM = 1024;
constexpr int LDK = 1088, LDF = 4160, LDV = 2112;
constexpr int PXW = 2176;
constexpr int PX_Q = 0, PX_K = 512, PX_GA = 640, PX_CA = 1152, PX_CB = 1408, PX_GC = 1664, PX_GF = 1920;
constexpr int NINP = 2816;
constexpr int LDS_BYTES = 65536;

struct Params {
    const float *x, *c, *ctx, *c_ctx, *w_ada, *b_ada, *norm_g, *w_in, *attn_sink, *conv_w, *conv_b, *conv_ln_g, *conv_ln_b,
        *w_four, *b_four, *w_out, *final_g;
    float* out;
    unsigned* bar;
    float* mod;
    float* rope;
    float* wc;
    bf16_t* winT;
    bf16_t* woutT;
    bf16_t* dft;
    bf16_t* dftc;
    bf16_t* hx;
    bf16_t* px;
    bf16_t* vtl;
    bf16_t* vtc;
    bf16_t* fbl;
    bf16_t* fbc;
    bf16_t* ycat;
    float* x1c;
    float* fscr;
    float* rowss;
    float* rowss2;
    unsigned* pcnt;
    float* sw;
};

DEV float bf2f(bf16_t v) { return __uint_as_float(((unsigned)v) << 16); }
typedef __bf16 bf16v2 __attribute__((ext_vector_type(2)));
typedef float f32v2 __attribute__((ext_vector_type(2)));
DEV unsigned cvtpk(float lo, float hi) { f32v2 v = {lo, hi}; bf16v2 b = __builtin_convertvector(v, bf16v2); return __builtin_bit_cast(unsigned, b); }
DEV float silu_f(float v) { return v * __builtin_amdgcn_rcpf(1.f + __expf(-v)); }
DEV float sigm_f(float v) { return __builtin_amdgcn_rcpf(1.f + __expf(-v)); }
DEV int opaque_tid() { int t = threadIdx.x; asm volatile("" : "+v"(t)); return t; }
DEV float lo_bf(unsigned u) { return __uint_as_float(u << 16); }
DEV float hi_bf(unsigned u) { return __uint_as_float(u & 0xffff0000u); }

#define XB_TMO      128
#define XB_XCNT(j)  (256  + 64 * (j))
#define XB_XSUB(j)  (1280 + 64 * (j))
#define XB_XGEN(j)  (2304 + 64 * (j))
#define XB_TOP      3328
#define XB_TOPGEN   3392
#define XCD_BAR_WORDS 3456
#define XB_SPIN_CAP (1u << 22)
#define LAS __attribute__((address_space(3)))
DEV unsigned xb_ld(unsigned* p) { return __hip_atomic_load(p, __ATOMIC_RELAXED, __HIP_MEMORY_SCOPE_AGENT); }
DEV unsigned xb_add(unsigned* p, unsigned v) { return __hip_atomic_fetch_add(p, v, __ATOMIC_RELAXED, __HIP_MEMORY_SCOPE_AGENT); }
DEV unsigned xb_xcc_id() { return (unsigned)__builtin_amdgcn_s_getreg((3 << 11) | 20) & 0xFu; }
#define XB_SPIN(cond, bar) do { unsigned _sp = 0; while (cond) { __builtin_amdgcn_s_sleep(1); \
    if ((++_sp & 255u) == 0u) { if (xb_ld(&(bar)[XB_TMO])) break; if (_sp > XB_SPIN_CAP) { atomicAdd(&(bar)[XB_TMO], 1u); break; } } } } while (0)
struct XcdBarrier { unsigned* bar; unsigned x; unsigned nloc, nx; };
DEV XcdBarrier xcd_barrier_post(unsigned* bar) {
    XcdBarrier b; b.bar = bar; b.x = xb_xcc_id(); b.nloc = 0u; b.nx = 0u;
    if (threadIdx.x == 0) (void)xb_add(&bar[XB_XCNT(b.x)], 1u);
    return b;
}
DEV void xcd_barrier_complete(unsigned* bar, unsigned x, unsigned& nloc, unsigned& nx) {
    const unsigned G = gridDim.x * gridDim.y * gridDim.z;
    unsigned sum, cnt, mine, sp = 0u;
    for (;;) {
        sum = 0u; cnt = 0u; mine = 0u;
#pragma unroll
        for (unsigned j = 0; j < 16; ++j) { const unsigned c = xb_ld(&bar[XB_XCNT(j)]); sum += c; cnt += (c > 0u) ? 1u : 0u; mine = (j == x) ? c : mine; }
        if (sum == G) break;
        __builtin_amdgcn_s_sleep(1);
        if ((++sp & 255u) == 0u) { if (xb_ld(&bar[XB_TMO])) break; if (sp > XB_SPIN_CAP) { atomicAdd(&bar[XB_TMO], 1u); break; } }
    }
    nloc = mine > 0u ? mine : 1u; nx = cnt > 0u ? cnt : 1u;
}
DEV void xcd_barrier(XcdBarrier& b) {
    asm volatile("s_waitcnt vmcnt(0)" ::: "memory");
    __syncthreads();
    if (threadIdx.x == 0) {
        unsigned* bar = b.bar;
        __builtin_amdgcn_s_waitcnt(0);
        unsigned nloc = b.nloc, nx = b.nx;
        if (nloc == 0u) { xcd_barrier_complete(bar, b.x, nloc, nx); b.nloc = nloc; b.nx = nx; }
        const unsigned old = xb_add(&bar[XB_XSUB(b.x)], 1u);
        const unsigned gen = old / nloc;
        if (old + 1u == (gen + 1u) * nloc) {
            __builtin_amdgcn_fence(__ATOMIC_RELEASE, "agent");
            asm volatile("s_waitcnt vmcnt(0)" ::: "memory");
            const unsigned og = xb_add(&bar[XB_TOP], 1u);
            const unsigned tg = og / nx;
            if (og + 1u == (tg + 1u) * nx) xb_add(&bar[XB_TOPGEN], 1u);
            else XB_SPIN(xb_ld(&bar[XB_TOPGEN]) == tg, bar);
            __builtin_amdgcn_fence(__ATOMIC_ACQUIRE, "agent");
            xb_add(&bar[XB_XGEN(b.x)], 1u);
            asm volatile("s_waitcnt vmcnt(0)" ::: "memory");
        } else {
            XB_SPIN(xb_ld(&bar[XB_XGEN(b.x)]) == gen, bar);
            __builtin_amdgcn_fence(__ATOMIC_ACQUIRE, "agent");
            asm volatile("s_waitcnt vmcnt(0)" ::: "memory");
        }
    }
    __syncthreads();
}

__device__ void ada_item(const Params& p, int item, float* lds) {
    const int tid = opaque_tid();
    const int l = item / 192, r = item % 192, kc = r / 12, jc = r % 12;
    const int k0 = kc * 64, j = jc * 256 + tid;
    __syncthreads();
#pragma unroll
    for (int q = 0; q < 3; ++q) {
        const int idx = tid + 256 * q;
        if (idx < 576) {
            const int b = idx >> 6, kk = idx & 63;
            const float v = (b < 8) ? p.c[b * 1024 + k0 + kk] : p.c_ctx[k0 + kk];
            lds[idx] = v * __builtin_amdgcn_rcpf(1.f + __expf(-v));
        }
    }
    __syncthreads();
    float acc[9];
#pragma unroll
    for (int b = 0; b < 9; ++b) acc[b] = 0.f;
    const float* wp = p.w_ada + (size_t)l * 1024 * 3072 + (size_t)k0 * 3072 + j;
#pragma unroll 32
    for (int kk = 0; kk < 64; ++kk) {
        const float wv = wp[(size_t)kk * 3072];
#pragma unroll
        for (int b = 0; b < 9; ++b) acc[b] += lds[b * 64 + kk] * wv;
    }
    const float bias = (kc == 0) ? p.b_ada[l * 3072 + j] : 0.f;
#pragma unroll
    for (int b = 0; b < 9; ++b) atomicAdd(p.mod + ((size_t)l * 9 + b) * 3072 + j, acc[b] + bias);
}

__device__ void wc_item(const Params& p, int item, const float* tab) {
    const int tid = opaque_tid(), lane = tid & 63, w = tid >> 6, li = lane & 31, kk = lane >> 5;
    const int jq = item & 1, ct = (item >> 1) & 1, h = (item >> 2) & 3, part = (item >> 4) & 1, l = item >> 5;
    const int cc = ct * 32 + li, j0 = jq * 128 + w * 32;
    const int ph = part ? 1536 : 0;
    const float* wf = p.w_four + (size_t)l * 65536 + (size_t)(h * 64 + kk) * 256 + j0 + li;
    f32x16 acc;
#pragma unroll
    for (int e = 0; e < 16; ++e) acc[e] = 0.f;
#pragma unroll 8
    for (int t = 0; t < 32; ++t) {
        const int m = 2 * t + kk;
        acc = __builtin_amdgcn_mfma_f32_32x32x2f32(tab[(32 * cc * m + ph) & 2047], wf[(2 * t) * 256], acc, 0, 0, 0);
    }
    float* op = p.wc + ((size_t)(l * 2 + part) * 256 + h * 64 + ct * 32 + 4 * kk) * 256 + j0 + li;
#pragma unroll
    for (int e = 0; e < 16; ++e) op[((e & 3) + 8 * (e >> 2)) * 256] = acc[e] * 0.125f;
}

__device__ void transpose_tile(const float* src, int sld, bf16_t* dst, int dld, float* t) {
    const int tid = opaque_tid();
    __syncthreads();
#pragma unroll
    for (int i = 0; i < 4; ++i) {
        const int id = tid + 256 * i, k = id >> 4, c = id & 15;
        const float4 v = *(const float4*)(src + (size_t)k * sld + c * 4);
        t[k * 65 + c * 4 + 0] = v.x; t[k * 65 + c * 4 + 1] = v.y; t[k * 65 + c * 4 + 2] = v.z; t[k * 65 + c * 4 + 3] = v.w;
    }
    __syncthreads();
    const int n = tid >> 2, kq = tid & 3;
    unsigned o[8];
#pragma unroll
    for (int e = 0; e < 8; ++e) o[e] = cvtpk(t[(kq * 16 + 2 * e) * 65 + n], t[(kq * 16 + 2 * e + 1) * 65 + n]);
    uint4* d = (uint4*)(dst + (size_t)n * dld + kq * 16);
    d[0] = make_uint4(o[0], o[1], o[2], o[3]);
    d[1] = make_uint4(o[4], o[5], o[6], o[7]);
}

DEV int win_dst_row(int n) {
    if (n < 640) return n;
    if (n < 768) return 2176 + (n - 640);
    if (n < 1280) return 640 + (n - 768);
    if (n < 1536) return 1152 + (n - 1280);
    if (n < 1792) return 1408 + (n - 1536);
    if (n < 2048) return 1664 + (n - 1792);
    return 1920 + (n - 2304);
}

__device__ void dft_item(const Params& p, int item, const float* tab) {
    const int tid = opaque_tid();
#pragma unroll
    for (int q = 0; q < 4; ++q) {
        const int idx = ((item * 4 + q) * 256 + tid) * 8;
        const int k = idx >> 12, n0 = idx & 4095;
        const int ph = (n0 < 2048) ? 0 : 512;
        unsigned o[4];
#pragma unroll
        for (int e = 0; e < 4; ++e) {
            const int n = (n0 + 2 * e) & 2047;
            o[e] = cvtpk(tab[(k * n + ph) & 2047], tab[(k * (n + 1) + ph) & 2047]);
        }
        *(uint4*)(p.dft + (size_t)k * LDF + n0) = make_uint4(o[0], o[1], o[2], o[3]);
    }
}
__device__ void dftc_item(const Params& p, int item, const float* tab) {
    const int idx = (item * 256 + opaque_tid()) * 8;
    const int k = idx >> 9, n0 = idx & 511;
    const int ph = (n0 < 256) ? 0 : 512;
    unsigned o[4];
#pragma unroll
    for (int e = 0; e < 4; ++e) {
        const int n = (n0 + 2 * e) & 255;
        o[e] = cvtpk(tab[(8 * k * n + ph) & 2047], tab[(8 * k * (n + 1) + ph) & 2047]);
    }
    *(uint4*)(p.dftc + idx) = make_uint4(o[0], o[1], o[2], o[3]);
}
__device__ void rope_item(const Params& p) {
    for (int i = threadIdx.x; i < 96 * 16; i += 256) {
        const int pp = i >> 4, f = i & 15;
        const float pos = (float)(pp < 32 ? pp : pp - 32);
        const float freq = powf(10000.f, -(float)f / 16.f);
        const float ang = pos * freq;
        p.rope[i * 2] = cosf(ang); p.rope[i * 2 + 1] = sinf(ang);
    }
}

__device__ void phase0(const Params& p, unsigned char* lds) {
    constexpr int N_ADA = 384, N_WC = 64;
    float* tab = (float*)(lds + 57344);
    for (int i = threadIdx.x; i < 2048; i += 256) tab[i] = cospif((float)i * (1.f / 1024.f));
    __syncthreads();
    for (int it = blockIdx.x; it < N_ADA + N_WC; it += gridDim.x) {
        if (it < N_WC) wc_item(p, it, tab);
        else ada_item(p, it - N_WC, (float*)lds);
    }
}
__device__ void phase1_prep(const Params& p, int it, unsigned char* lds) {
    constexpr int O3 = 1152, O4 = O3 + 512, O5 = O4 + 1024, O6 = O5 + 64;
    const float* tab = (const float*)(lds + 57344);
    if (it < O3) {
        const int q = it, l = q / 576, r = q % 576, ct = r >> 4, kt = r & 15;
        const int n0 = ct < 32 ? ct * 64 : 2304 + (ct - 32) * 64;
        transpose_tile(p.w_in + (size_t)l * 1024 * 2560 + (size_t)(kt * 64) * 2560 + n0, 2560,
                       p.winT + (size_t)l * NINP * LDK + (size_t)win_dst_row(n0) * LDK + kt * 64, LDK, (float*)lds);
    } else if (it < O4) {
        const int q = it - O3, l = q >> 8, r = q & 255, ct = r >> 4, kt = r & 15;
        transpose_tile(p.w_out + (size_t)l * 1048576 + (size_t)(kt * 64) * 1024 + ct * 64, 1024,
                       p.woutT + (size_t)l * 1024 * LDK + (size_t)(ct * 64) * LDK + kt * 64, LDK, (float*)lds);
    } else if (it < O5) dft_item(p, it - O4, tab);
    else if (it < O6) dftc_item(p, it - O5, tab);
    else rope_item(p);
}
constexpr int P1_PREP = 1152 + 512 + 1024 + 64 + 1;

__device__ void fold_item(const Params& p, int item, float* lds) {
    const int tid = opaque_tid(), lane = tid & 63, w = tid >> 6, wr = w >> 1, wc = w & 1, li = lane & 31, kk = lane >> 5;
    const int l = item >> 7, part = (item >> 6) & 1, kt = (item >> 2) & 15, jt = item & 3;
    const int k0 = kt * 64 + wr * 32, j0 = jt * 64 + wc * 32;
    const float* ap = p.w_in + (size_t)l * 1024 * 2560 + (size_t)(k0 + li) * 2560 + 2048 + 4 * kk;
    const float* bp = p.wc + ((size_t)(l * 2 + part) * 256 + 4 * kk) * 256 + j0 + li;
    f32x16 acc;
#pragma unroll
    for (int e = 0; e < 16; ++e) acc[e] = 0.f;
#pragma unroll 4
    for (int u = 0; u < 32; ++u) {
        const float4 a = *(const float4*)(ap + 8 * u);
        const float b0 = bp[(8 * u + 0) * 256], b1 = bp[(8 * u + 1) * 256], b2 = bp[(8 * u + 2) * 256], b3 = bp[(8 * u + 3) * 256];
        acc = __builtin_amdgcn_mfma_f32_32x32x2f32(a.x, b0, acc, 0, 0, 0);
        acc = __builtin_amdgcn_mfma_f32_32x32x2f32(a.y, b1, acc, 0, 0, 0);
        acc = __builtin_amdgcn_mfma_f32_32x32x2f32(a.z, b2, acc, 0, 0, 0);
        acc = __builtin_amdgcn_mfma_f32_32x32x2f32(a.w, b3, acc, 0, 0, 0);
    }
    bf16_t* op = p.winT + (size_t)l * NINP * LDK + (size_t)(2304 + part * 256 + j0 + li) * LDK + k0 + 4 * kk;
#pragma unroll
    for (int g = 0; g < 4; ++g)
        *(uint2*)(op + 8 * g) = make_uint2(cvtpk(acc[4 * g + 0], acc[4 * g + 1]), cvtpk(acc[4 * g + 2], acc[4 * g + 3]));
}

__device__ void hx_item(const Params& p, int l, int item) {
    const int tid = opaque_tid(), lane = tid & 63, w = tid >> 6;
    const int m0 = item * 8 + w * 2;
    const float* src0;
    if (l == 0) src0 = (m0 < NTOK) ? p.x + (size_t)m0 * DM : p.ctx + (size_t)(m0 - NTOK) * DM;
    else src0 = (m0 < NTOK) ? p.out + (size_t)m0 * DM : p.x1c + (size_t)(m0 - NTOK) * DM;
    const int b = (m0 < NTOK) ? (m0 >> 11) : 8;
    float4 v[2][4];
#pragma unroll
    for (int rr = 0; rr < 2; ++rr)
#pragma unroll
        for (int i = 0; i < 4; ++i) v[rr][i] = *(const float4*)(src0 + rr * DM + i * 256 + lane * 4);
    const float* g = p.norm_g + l * DM;
    const float* sh = p.mod + ((size_t)l * 9 + b) * 3072;
    const float* sc = sh + 1024;
    float4 gm[4], hm[4];
#pragma unroll
    for (int i = 0; i < 4; ++i) {
        const int col = i * 256 + lane * 4;
        const float4 gg = *(const float4*)(g + col), s4 = *(const float4*)(sc + col);
        hm[i] = *(const float4*)(sh + col);
        gm[i] = make_float4(gg.x * (1.f + s4.x), gg.y * (1.f + s4.y), gg.z * (1.f + s4.z), gg.w * (1.f + s4.w));
    }
#pragma unroll
    for (int rr = 0; rr < 2; ++rr) {
        float ss = 0.f;
#pragma unroll
        for (int i = 0; i < 4; ++i) ss += v[rr][i].x * v[rr][i].x + v[rr][i].y * v[rr][i].y + v[rr][i].z * v[rr][i].z + v[rr][i].w * v[rr][i].w;
#pragma unroll
        for (int o = 32; o >= 1; o >>= 1) ss += __shfl_xor(ss, o);
        const float rstd = rsqrtf(ss * (1.f / 1024.f) + 1e-6f);
#pragma unroll
        for (int i = 0; i < 4; ++i) {
            const int col = i * 256 + lane * 4;
            const float a0 = v[rr][i].x * rstd * gm[i].x + hm[i].x;
            const float a1 = v[rr][i].y * rstd * gm[i].y + hm[i].y;
            const float a2 = v[rr][i].z * rstd * gm[i].z + hm[i].z;
            const float a3 = v[rr][i].w * rstd * gm[i].w + hm[i].w;
            *(uint2*)(p.hx + (size_t)(m0 + rr) * LDK + col) = make_uint2(cvtpk(a0, a1), cvtpk(a2, a3));
        }
    }
}

template <bool SWAP>
DEV void gemm_core(const bf16_t* __restrict__ A, int lda, const bf16_t* __restrict__ Bt, int ldb, int K, unsigned char* lds, f32x4 (&acc)[4][4]) {
    const int tid = opaque_tid(), lane = tid & 63, w = tid >> 6, wr = w >> 1, wc = w & 1;
    const int fr = lane & 15, fq = lane >> 4;
    const int srow = tid >> 3, sc = (tid & 7) ^ ((srow >> 1) & 7);
    const bf16_t* ga = A + (size_t)srow * lda + sc * 8;
    const bf16_t* gb = Bt + (size_t)srow * ldb + sc * 8;
    unsigned char* la = lds + __builtin_amdgcn_readfirstlane(tid >> 6) * 1024;
#define GEMM_STAGE(buf, kt) do { \
        _Pragma("unroll") for (int _i = 0; _i < 4; ++_i) { \
            __builtin_amdgcn_global_load_lds((const unsigned*)(ga + (size_t)(32 * _i) * lda + (kt) * 64), (unsigned*)(la + (buf) * 32768 + _i * 4096), 16, 0, 0); \
            __builtin_amdgcn_global_load_lds((const unsigned*)(gb + (size_t)(32 * _i) * ldb + (kt) * 64), (unsigned*)(la + (buf) * 32768 + 16384 + _i * 4096), 16, 0, 0); \
        } } while (0)
#pragma unroll
    for (int i = 0; i < 4; ++i)
#pragma unroll
        for (int j = 0; j < 4; ++j) acc[i][j] = (f32x4){0.f, 0.f, 0.f, 0.f};
    const int nk = K >> 6;
    const int po0 = (fq ^ (fr >> 1)) * 16, po1 = ((4 + fq) ^ (fr >> 1)) * 16;
    const unsigned char* fa = lds + (wr * 64 + fr) * 128;
    const unsigned char* fb = lds + 16384 + (wc * 64 + fr) * 128;
    __syncthreads();
    GEMM_STAGE(0, 0);
    for (int kt = 0; kt < nk; ++kt) {
        asm volatile("s_waitcnt vmcnt(0)" ::: "memory");
        __syncthreads();
        const int buf = kt & 1;
        if (kt + 1 < nk) GEMM_STAGE(buf ^ 1, kt + 1);
        bf16x8 af[2][4], bfr[2][4];
#pragma unroll
        for (int ks = 0; ks < 2; ++ks) {
            const int po = ks ? po1 : po0;
            bfr[ks][0] = *(const bf16x8*)(fb + buf * 32768 + 0 * 2048 + po);
            af[ks][0] = *(const bf16x8*)(fa + buf * 32768 + 0 * 2048 + po);
#pragma unroll
            for (int j = 1; j < 4; ++j) bfr[ks][j] = *(const bf16x8*)(fb + buf * 32768 + j * 2048 + po);
#pragma unroll
            for (int i = 1; i < 4; ++i) af[ks][i] = *(const bf16x8*)(fa + buf * 32768 + i * 2048 + po);
        }
#pragma unroll
        for (int ks = 0; ks < 2; ++ks)
#pragma unroll
            for (int i = 0; i < 4; ++i)
#pragma unroll
                for (int j = 0; j < 4; ++j) {
                    if (SWAP) acc[i][j] = __builtin_amdgcn_mfma_f32_16x16x32_bf16(bfr[ks][j], af[ks][i], acc[i][j], 0, 0, 0);
                    else      acc[i][j] = __builtin_amdgcn_mfma_f32_16x16x32_bf16(af[ks][i], bfr[ks][j], acc[i][j], 0, 0, 0);
                }
        __builtin_amdgcn_sched_group_barrier(0x100, 5, 0);
#pragma unroll
        for (int q = 0; q < 11; ++q) { __builtin_amdgcn_sched_group_barrier(0x008, 1, 0); __builtin_amdgcn_sched_group_barrier(0x100, 1, 0); }
        __builtin_amdgcn_sched_group_barrier(0x008, 21, 0);
    }
#undef GEMM_STAGE
}

__device__ void inproj_tile(const Params& p, int l, int mt, int nt, unsigned char* lds) {
    const int tid = opaque_tid(), lane = tid & 63, w = tid >> 6, wr = w >> 1, wc = w & 1, fr = lane & 15, fq = lane >> 4;
    const bf16_t* A = p.hx + (size_t)(mt * 128) * LDK;
    const bf16_t* Bt = p.winT + (size_t)l * NINP * LDK + (size_t)(nt * 128) * LDK;
    f32x4 acc[4][4];
    const bool latent = mt < 128;
    const int bb = latent ? (mt >> 4) : 8;
    if (nt < 17) {
        f32x4 bias[4]; float rss[4];
        if (l == 1) {
#pragma unroll
            for (int j = 0; j < 4; ++j) bias[j] = *(const f32x4*)(p.sw + (size_t)bb * NINP + nt * 128 + wc * 64 + j * 16 + fq * 4);
#pragma unroll
            for (int i = 0; i < 4; ++i) rss[i] = p.rowss[mt * 128 + wr * 64 + i * 16 + fr];
        }
        gemm_core<true>(A, LDK, Bt, LDK, 1024, lds, acc);
        if (l == 1) {
#pragma unroll
            for (int i = 0; i < 4; ++i) {
                const float rstd = rsqrtf(rss[i] * (1.f / 1024.f) + 1e-6f);
#pragma unroll
                for (int j = 0; j < 4; ++j) acc[i][j] = acc[i][j] * rstd + bias[j];
            }
        }
        const bool isq = nt < 4, isk = nt == 4;
        const bool gated = (nt >= 5 && nt <= 8) || (nt >= 13);
#pragma unroll
        for (int i = 0; i < 4; ++i) {
            const int m = mt * 128 + wr * 64 + i * 16 + fr;
            if ((isq || isk) && latent) {
                const int t = m & 2047, rp = t >> 6, cp = 32 + (t & 63);
                const float4* r1 = (const float4*)(p.rope + (rp * 16 + fq * 4) * 2);
                const float4* r2 = (const float4*)(p.rope + (cp * 16 + fq * 4) * 2);
                const float4 ra0 = r1[0], ra1 = r1[1], rb0 = r2[0], rb1 = r2[1];
                const float cr[4] = {ra0.x, ra0.z, ra1.x, ra1.z}, sr[4] = {ra0.y, ra0.w, ra1.y, ra1.w};
                const float cc[4] = {rb0.x, rb0.z, rb1.x, rb1.z}, sc[4] = {rb0.y, rb0.w, rb1.y, rb1.w};
#pragma unroll
                for (int e = 0; e < 4; ++e) {
                    const float x1 = acc[i][0][e], x2 = acc[i][1][e];
                    acc[i][0][e] = x1 * cr[e] - x2 * sr[e]; acc[i][1][e] = x1 * sr[e] + x2 * cr[e];
                    const float y1 = acc[i][2][e], y2 = acc[i][3][e];
                    acc[i][2][e] = y1 * cc[e] - y2 * sc[e]; acc[i][3][e] = y1 * sc[e] + y2 * cc[e];
                }
            }
            bf16_t* orow = p.px + (size_t)m * PXW + nt * 128 + wc * 64 + fq * 4;
#pragma unroll
            for (int j = 0; j < 4; ++j) {
                f32x4 v = acc[i][j];
                if (isq) v = v * 0.18033688011112042f;
                if (gated) { v[0] = silu_f(v[0]); v[1] = silu_f(v[1]); v[2] = silu_f(v[2]); v[3] = silu_f(v[3]); }
                *(uint2*)(orow + j * 16) = make_uint2(cvtpk(v[0], v[1]), cvtpk(v[2], v[3]));
            }
        }
    } else {
        gemm_core<false>(A, LDK, Bt, LDK, 1024, lds, acc);
        if (l == 1) {
            float bias[4];
#pragma unroll
            for (int j = 0; j < 4; ++j) bias[j] = p.sw[(size_t)bb * NINP + nt * 128 + wc * 64 + j * 16 + fr];
#pragma unroll
            for (int i = 0; i < 4; ++i) {
                const float4 ss = *(const float4*)(p.rowss + mt * 128 + wr * 64 + i * 16 + fq * 4);
                const f32x4 rs = {rsqrtf(ss.x * (1.f / 1024.f) + 1e-6f), rsqrtf(ss.y * (1.f / 1024.f) + 1e-6f), rsqrtf(ss.z * (1.f / 1024.f) + 1e-6f), rsqrtf(ss.w * (1.f / 1024.f) + 1e-6f)};
#pragma unroll
                for (int j = 0; j < 4; ++j) acc[i][j] = acc[i][j] * rs + bias[j];
            }
        }
        int b, t0, T;
        if (latent) { b = mt >> 4; t0 = (mt & 15) * 128; T = 2048; }
        else { const int q = mt - 128; b = q >> 1; t0 = (q & 1) * 128; T = 256; }
        bf16_t* base; size_t ld;
        if (nt == 17) { ld = latent ? LDV : 256; base = (latent ? p.vtl : p.vtc) + (size_t)(b * 128) * ld; }
        else {
            const int part = (nt >= 20), jb = ((nt - 18) & 1) * 128;
            ld = latent ? LDF : 512;
            base = (latent ? p.fbl : p.fbc) + ((size_t)(b * 256 + jb)) * ld + part * T;
        }
#pragma unroll
        for (int i = 0; i < 4; ++i) {
            const int t = t0 + wr * 64 + i * 16 + fq * 4;
#pragma unroll
            for (int j = 0; j < 4; ++j) {
                const int n = wc * 64 + j * 16 + fr;
                const f32x4 v = acc[i][j];
                *(uint2*)(base + (size_t)n * ld + t) = make_uint2(cvtpk(v[0], v[1]), cvtpk(v[2], v[3]));
            }
        }
    }
}

__device__ void fourier_tile(const Params& p, int l, int it, unsigned char* lds) {
    const int tid = opaque_tid(), lane = tid & 63, w = tid >> 6, wr = w >> 1, wc = w & 1, fr = lane & 15, fq = lane >> 4;
    const bf16_t *A, *Bt; int ld, N, tok0, k0, nt; float scale;
    if (it < 128) {
        const int b = it >> 4, kt = (it >> 1) & 7; nt = it & 1;
        A = p.dft + (size_t)(kt * 128) * LDF; Bt = p.fbl + (size_t)(b * 256 + nt * 128) * LDF; ld = LDF; N = 2048;
        tok0 = b * 2048; k0 = kt * 128; scale = 0.022097086912079608f;
    } else {
        const int q = it - 128, b = q >> 1; nt = q & 1;
        A = p.dftc; Bt = p.fbc + (size_t)(b * 256 + nt * 128) * 512; ld = 512; N = 256;
        tok0 = NTOK + b * 256; k0 = 0; scale = 0.0625f;
    }
    f32x4 accP[4][4], accQ[4][4];
    f32x4* scr = (f32x4*)(p.fscr + (size_t)blockIdx.x * 16384) + tid;
    gemm_core<true>(A, ld, Bt, ld, N, lds, accQ);
#pragma unroll
    for (int i = 0; i < 4; ++i)
#pragma unroll
        for (int j = 0; j < 4; ++j) scr[(i * 4 + j) * 256] = accQ[i][j];
    gemm_core<true>(A + N, ld, Bt + N, ld, N, lds, accQ);
#pragma unroll
    for (int i = 0; i < 4; ++i)
#pragma unroll
        for (int j = 0; j < 4; ++j) accP[i][j] = scr[(i * 4 + j) * 256];
#pragma unroll
    for (int i = 0; i < 4; ++i) {
        const int k = k0 + wr * 64 + i * 16 + fr;
        const int m1 = tok0 + k, m2 = tok0 + N - k;
#pragma unroll
        for (int j = 0; j < 4; ++j) {
            const int jc = nt * 128 + wc * 64 + j * 16 + fq * 4;
            const float4 bb = *(const float4*)(p.b_four + l * 256 + jc);
            const f32x4 vp = accP[i][j], vq = accQ[i][j];
            {
                const uint2 g = *(const uint2*)(p.px + (size_t)m1 * PXW + PX_GF + jc);
                const float o0 = ((vp[0] + vq[0]) * scale + bb.x) * lo_bf(g.x), o1 = ((vp[1] + vq[1]) * scale + bb.y) * hi_bf(g.x);
                const float o2 = ((vp[2] + vq[2]) * scale + bb.z) * lo_bf(g.y), o3 = ((vp[3] + vq[3]) * scale + bb.w) * hi_bf(g.y);
                *(uint2*)(p.ycat + (size_t)m1 * LDK + 768 + jc) = make_uint2(cvtpk(o0, o1), cvtpk(o2, o3));
            }
            if (k != 0) {
                const uint2 g = *(const uint2*)(p.px + (size_t)m2 * PXW + PX_GF + jc);
                const float o0 = ((vp[0] - vq[0]) * scale + bb.x) * lo_bf(g.x), o1 = ((vp[1] - vq[1]) * scale + bb.y) * hi_bf(g.x);
                const float o2 = ((vp[2] - vq[2]) * scale + bb.z) * lo_bf(g.y), o3 = ((vp[3] - vq[3]) * scale + bb.w) * hi_bf(g.y);
                *(uint2*)(p.ycat + (size_t)m2 * LDK + 768 + jc) = make_uint2(cvtpk(o0, o1), cvtpk(o2, o3));
            }
        }
    }
}
__device__ void nyq_item(const Params& p, int l, int it) {
    const int tid = opaque_tid(), lane = tid & 63, w = tid >> 6;
    const bool lat = it < 256;
    const int q = lat ? it : it - 256, b = q >> 5, j0 = (q & 31) * 8 + w * 2;
    const int N = lat ? 2048 : 256, tok = lat ? (b * 2048 + 1024) : (NTOK + b * 256 + 128);
    const bf16_t* fb = lat ? (p.fbl + (size_t)(b * 256) * LDF) : (p.fbc + (size_t)(b * 256) * 512);
    const int fld = lat ? LDF : 512;
    const float scale = lat ? 0.022097086912079608f : 0.0625f;
    u32x4 v[2][4];
#pragma unroll
    for (int jj = 0; jj < 2; ++jj)
#pragma unroll
        for (int c = 0; c < 4; ++c) {
            const int ch = lane + 64 * c;
            v[jj][c] = (ch < (N >> 3)) ? *(const u32x4*)(fb + (size_t)(j0 + jj) * fld + ch * 8) : (u32x4){0u, 0u, 0u, 0u};
        }
    float gpre[2], bpre[2];
#pragma unroll
    for (int jj = 0; jj < 2; ++jj) { gpre[jj] = bf2f(p.px[(size_t)tok * PXW + PX_GF + j0 + jj]); bpre[jj] = p.b_four[l * 256 + j0 + jj]; }
#pragma unroll
    for (int jj = 0; jj < 2; ++jj) {
        float s = 0.f;
#pragma unroll
        for (int c = 0; c < 4; ++c)
#pragma unroll
            for (int e = 0; e < 4; ++e) s += lo_bf(v[jj][c][e]) - hi_bf(v[jj][c][e]);
#pragma unroll
        for (int o = 32; o >= 1; o >>= 1) s += __shfl_xor(s, o);
        if (lane == 0) {
            const int j = j0 + jj;
            const float o = (s * scale + bpre[jj]) * gpre[jj];
            p.ycat[(size_t)tok * LDK + 768 + j] = (bf16_t)(cvtpk(o, 0.f) & 0xffffu);
        }
    }
}

__device__ void sw_item(const Params& p, int it) {
    const int tid = opaque_tid(), lane = tid & 63, w = tid >> 6;
    const int n0 = it * 16 + w * 4;
    float wv[4][16];
#pragma unroll
    for (int c = 0; c < 4; ++c) {
        const bf16_t* wr_ = p.winT + (size_t)NINP * LDK + (size_t)(n0 + c) * LDK + lane * 16;
        const u32x4 u0 = *(const u32x4*)(wr_), u1 = *(const u32x4*)(wr_ + 8);
#pragma unroll
        for (int e = 0; e < 4; ++e) { wv[c][2 * e] = lo_bf(u0[e]); wv[c][2 * e + 1] = hi_bf(u0[e]); wv[c][8 + 2 * e] = lo_bf(u1[e]); wv[c][8 + 2 * e + 1] = hi_bf(u1[e]); }
    }
#pragma unroll 3
    for (int b = 0; b < 9; ++b) {
        const float* sh = p.mod + ((size_t)9 + b) * 3072 + lane * 16;
        float hv[16];
#pragma unroll
        for (int q = 0; q < 4; ++q) { const float4 t = *(const float4*)(sh + 4 * q); hv[4 * q] = t.x; hv[4 * q + 1] = t.y; hv[4 * q + 2] = t.z; hv[4 * q + 3] = t.w; }
        float acc[4];
#pragma unroll
        for (int c = 0; c < 4; ++c) {
            float a = 0.f;
#pragma unroll
            for (int e = 0; e < 16; ++e) a += hv[e] * wv[c][e];
#pragma unroll
            for (int o = 32; o >= 1; o >>= 1) a += __shfl_xor(a, o);
            acc[c] = a;
        }
        if (lane == 0) *(float4*)(p.sw + (size_t)b * NINP + n0) = make_float4(acc[0], acc[1], acc[2], acc[3]);
    }
}

__device__ void outproj_tile(const Params& p, int l, int mt, int nt, unsigned char* lds) {
    const int tid = opaque_tid(), lane = tid & 63, w = tid >> 6, wr = w >> 1, wc = w & 1, fr = lane & 15, fq = lane >> 4;
    f32x4 acc[4][4];
    gemm_core<true>(p.ycat + (size_t)(mt * 128) * LDK, LDK, p.woutT + (size_t)l * 1024 * LDK + (size_t)(nt * 128) * LDK, LDK, 1024, lds, acc);
    float* sC = (float*)lds;
    __syncthreads();
#pragma unroll
    for (int i = 0; i < 4; ++i) {
        const int row = wr * 64 + i * 16 + fr;
#pragma unroll
        for (int j = 0; j < 4; ++j) {
            const int c = wc * 16 + j * 4 + fq;
            *(f32x4*)(sC + row * 128 + ((c ^ (row & 7)) << 2)) = acc[i][j];
        }
    }
    __syncthreads();
    const int chunk = tid & 31, rsub = tid >> 5;
    const int n = nt * 128 + chunk * 4;
    const int m0 = mt * 128;
    const int b = (m0 < NTOK) ? (m0 >> 11) : 8;
    const float* xo; float* xn;
    if (m0 < NTOK) { xo = (l == 0 ? p.x : (const float*)p.out) + (size_t)m0 * DM + n; xn = p.out + (size_t)m0 * DM + n; }
    else { xo = p.ctx + (size_t)(m0 - NTOK) * DM + n; xn = p.x1c + (size_t)(m0 - NTOK) * DM + n; }
    const float4 g = *(const float4*)(p.mod + ((size_t)l * 9 + b) * 3072 + 2048 + n);
    float4 xv[16];
#pragma unroll
    for (int it = 0; it < 16; ++it) xv[it] = *(const float4*)(xo + (size_t)(it * 8 + rsub) * DM);
    float4 gs = make_float4(0.f, 0.f, 0.f, 0.f);
    if (l == 0) {
        const float4 g1 = *(const float4*)(p.norm_g + DM + n), s1 = *(const float4*)(p.mod + ((size_t)9 + b) * 3072 + 1024 + n);
        gs = make_float4(g1.x * (1.f + s1.x), g1.y * (1.f + s1.y), g1.z * (1.f + s1.z), g1.w * (1.f + s1.w));
    }
    if (l == 1) {
#pragma unroll
        for (int it = 0; it < 16; ++it) {
            const int row = it * 8 + rsub;
            const f32x4 v = *(const f32x4*)(sC + row * 128 + ((chunk ^ (row & 7)) << 2));
            const float4 o = make_float4(xv[it].x + g.x * v[0], xv[it].y + g.y * v[1], xv[it].z + g.z * v[2], xv[it].w + g.w * v[3]);
            xv[it] = o;
            float ss = o.x * o.x + o.y * o.y + o.z * o.z + o.w * o.w;
#pragma unroll
            for (int sh = 16; sh >= 1; sh >>= 1) ss += __shfl_xor(ss, sh);
            if (chunk == 0) atomicAdd(p.rowss2 + m0 + row, ss);
        }
        asm volatile("s_waitcnt vmcnt(0)" ::: "memory");
        __syncthreads();
        if (tid == 0) {
            unsigned* cnt = p.pcnt + mt * 16;
            __builtin_amdgcn_fence(__ATOMIC_RELEASE, "agent");
            asm volatile("s_waitcnt vmcnt(0)" ::: "memory");
            (void)__hip_atomic_fetch_add(cnt, 1u, __ATOMIC_RELAXED, __HIP_MEMORY_SCOPE_AGENT);
            unsigned sp = 0;
            while (__hip_atomic_load(cnt, __ATOMIC_RELAXED, __HIP_MEMORY_SCOPE_AGENT) < 8u) { __builtin_amdgcn_s_sleep(1); if (++sp > (1u << 22)) break; }
            __builtin_amdgcn_fence(__ATOMIC_ACQUIRE, "agent");
            asm volatile("s_waitcnt vmcnt(0)" ::: "memory");
        }
        __syncthreads();
        const float4 fg = *(const float4*)(p.final_g + n);
#pragma unroll
        for (int it = 0; it < 16; ++it) {
            const int row = it * 8 + rsub;
            const float ssum = __hip_atomic_load(p.rowss2 + m0 + row, __ATOMIC_RELAXED, __HIP_MEMORY_SCOPE_AGENT);
            const float rstd = rsqrtf(ssum * (1.f / 1024.f) + 1e-6f);
            *(float4*)(xn + (size_t)row * DM) = make_float4(xv[it].x * rstd * fg.x, xv[it].y * rstd * fg.y, xv[it].z * rstd * fg.z, xv[it].w * rstd * fg.w);
        }
        return;
    }
#pragma unroll
    for (int it = 0; it < 16; ++it) {
        const int row = it * 8 + rsub;
        const f32x4 v = *(const f32x4*)(sC + row * 128 + ((chunk ^ (row & 7)) << 2));
        const float4 o = make_float4(xv[it].x + g.x * v[0], xv[it].y + g.y * v[1], xv[it].z + g.z * v[2], xv[it].w + g.w * v[3]);
        *(float4*)(xn + (size_t)row * DM) = o;
        if (l == 0) {
            *(uint2*)(p.hx + (size_t)(m0 + row) * LDK + n) = make_uint2(cvtpk(o.x * gs.x, o.y * gs.y), cvtpk(o.z * gs.z, o.w * gs.w));
            float ss = o.x * o.x + o.y * o.y + o.z * o.z + o.w * o.w;
#pragma unroll
            for (int sh = 16; sh >= 1; sh >>= 1) ss += __shfl_xor(ss, sh);
            if (chunk == 0) atomicAdd(p.rowss + m0 + row, ss);
        }
    }
}

__device__ void attn_item(const Params& p, int l, int item, unsigned char* lds) {
    const int tid = opaque_tid(), lane = tid & 63, w = tid >> 6, r = lane & 31, hh = lane >> 5;
    int b, n, hp; bool isctx;
    if (item < 512) { b = item >> 6; n = (item >> 2) & 15; hp = item & 3; isctx = false; }
    else { const int q = item - 512; b = q >> 3; n = (q >> 2) & 1; hp = q & 3; isctx = true; }
    const int kvh = hp >> 1, h0 = hp * 2;
    const int qrow0 = isctx ? (NTOK + b * 256 + n * 128) : (b * 2048 + n * 128);
    int lo = 0, hi = 0;
    if (!isctx) { lo = (n - 1) * 128; if (lo < 0) lo = 0; hi = (n + 2) * 128; if (hi > 2048) hi = 2048; }
    const int ntiles = 4 + ((hi - lo) >> 6);
    const int qtok = qrow0 + w * 32 + r;
    const int qpos = n * 128 + w * 32 + r;
    bf16x8 qf[2][4];
#pragma unroll
    for (int hq = 0; hq < 2; ++hq) {
        const bf16_t* qp = p.px + (size_t)qtok * PXW + PX_Q + (h0 + hq) * 64 + 8 * hh;
#pragma unroll
        for (int s = 0; s < 4; ++s) qf[hq][s] = *(const bf16x8*)(qp + 16 * s);
    }
    const int lrow = tid >> 3, lchunk = (tid & 7) ^ ((lrow >> 1) & 7);
    unsigned char* la = lds + __builtin_amdgcn_readfirstlane(tid >> 6) * 1024;
    auto issue = [&](int ti) {
        const bf16_t *kb, *vb; int vld;
        if (ti < 4) { kb = p.px + (size_t)(NTOK + b * 256 + ti * 64) * PXW + PX_K + kvh * 64; vb = p.vtc + (size_t)(b * 128 + kvh * 64) * 256 + ti * 64; vld = 256; }
        else { const int pos0 = lo + (ti - 4) * 64; kb = p.px + (size_t)(b * 2048 + pos0) * PXW + PX_K + kvh * 64; vb = p.vtl + (size_t)(b * 128 + kvh * 64) * LDV + pos0; vld = LDV; }
        unsigned char* dst = la + (ti & 3) * 16384;
#pragma unroll
        for (int q = 0; q < 2; ++q) {
            __builtin_amdgcn_global_load_lds((const unsigned*)(kb + (size_t)(lrow + 32 * q) * PXW + lchunk * 8), (unsigned*)(dst + q * 4096), 16, 0, 0);
            __builtin_amdgcn_global_load_lds((const unsigned*)(vb + (size_t)(lrow + 32 * q) * vld + lchunk * 8), (unsigned*)(dst + 8192 + q * 4096), 16, 0, 0);
        }
    };
    const int fsw = (r >> 1) & 7;
    float sinkv[2], mrun[2], lsum[2];
    f32x16 O[2][2];
#pragma unroll
    for (int hq = 0; hq < 2; ++hq) {
        sinkv[hq] = p.attn_sink[l * 8 + h0 + hq] * 1.4426950408889634f; mrun[hq] = sinkv[hq]; lsum[hq] = 0.f;
#pragma unroll
        for (int e = 0; e < 16; ++e) { O[hq][0][e] = 0.f; O[hq][1][e] = 0.f; }
    }
    asm volatile("" :: "v"(qf[0][0]), "v"(qf[0][1]), "v"(qf[0][2]), "v"(qf[0][3]), "v"(qf[1][0]), "v"(qf[1][1]), "v"(qf[1][2]), "v"(qf[1][3]));
    __syncthreads();
    issue(0); issue(1); issue(2);
    const int wq0 = n * 128 + w * 32;
    for (int ti = 0; ti < ntiles; ++ti) {
        const int rem = ntiles - 1 - ti;
        if (rem >= 2) asm volatile("s_waitcnt vmcnt(8)" ::: "memory");
        else if (rem == 1) asm volatile("s_waitcnt vmcnt(4)" ::: "memory");
        else asm volatile("s_waitcnt vmcnt(0)" ::: "memory");
        __builtin_amdgcn_s_barrier();
        asm volatile("" ::: "memory");
        if (ti + 3 < ntiles) issue(ti + 3);
        const bool local = ti >= 4;
        const int pos0 = lo + (ti - 4) * 64;
        const unsigned char* kbuf = lds + (ti & 3) * 16384;
        const unsigned char* vbuf = kbuf + 8192;
#pragma unroll
        for (int kb = 0; kb < 2; ++kb) {
            const int k0 = pos0 + kb * 32;
            const int dlo = wq0 - k0 - 31, dhi = wq0 + 31 - k0;
            if (local && (dhi < -128 || dlo > 128)) continue;
            const bool partial = local && (dlo < -128 || dhi > 128);
            bf16x8 ka[4];
#pragma unroll
            for (int s = 0; s < 4; ++s) ka[s] = *(const bf16x8*)(kbuf + (kb * 32 + r) * 128 + (((2 * s + hh) ^ fsw) << 4));
            bf16x8 pf[2][2];
            f32x16 SS[2];
#pragma unroll
            for (int hq = 0; hq < 2; ++hq) {
#pragma unroll
                for (int e = 0; e < 16; ++e) SS[hq][e] = 0.f;
#pragma unroll
                for (int s = 0; s < 4; ++s) SS[hq] = __builtin_amdgcn_mfma_f32_32x32x16_bf16(ka[s], qf[hq][s], SS[hq], 0, 0, 0);
            }
#pragma unroll
            for (int hq = 0; hq < 2; ++hq) {
                f32x16 S = SS[hq];
                if (partial) {
#pragma unroll
                    for (int e = 0; e < 16; ++e) {
                        const int d = qpos - (k0 + (e & 3) + 8 * (e >> 2) + 4 * hh);
                        if (d > 128 || d < -128) S[e] = -1e30f;
                    }
                }
                float mx = __builtin_fmaxf(__builtin_fmaxf(S[0], S[1]), S[2]);
#pragma unroll
                for (int e = 3; e < 15; e += 2) mx = __builtin_fmaxf(__builtin_fmaxf(mx, S[e]), S[e + 1]);
                mx = __builtin_fmaxf(mx, S[15]);
                if (__any(mx > mrun[hq] + 8.f)) {
                    mx = fmaxf(mx, __shfl_xor(mx, 32));
                    const float mnew = fmaxf(mrun[hq], mx);
                    const float alpha = __builtin_amdgcn_exp2f(mrun[hq] - mnew);
                    mrun[hq] = mnew;
                    lsum[hq] *= alpha;
#pragma unroll
                    for (int e = 0; e < 16; ++e) { O[hq][0][e] *= alpha; O[hq][1][e] *= alpha; }
                }
                float ps0 = 0.f, ps1 = 0.f;
#pragma unroll
                for (int e = 0; e < 16; e += 2) {
                    const float p0 = __builtin_amdgcn_exp2f(S[e] - mrun[hq]), p1 = __builtin_amdgcn_exp2f(S[e + 1] - mrun[hq]);
                    S[e] = p0; S[e + 1] = p1; ps0 += p0; ps1 += p1;
                }
                lsum[hq] += ps0 + ps1;
#pragma unroll
                for (int s2 = 0; s2 < 2; ++s2) {
                    u32x4 pfu;
#pragma unroll
                    for (int e = 0; e < 4; ++e) pfu[e] = cvtpk(S[8 * s2 + 2 * e], S[8 * s2 + 2 * e + 1]);
                    pf[hq][s2] = __builtin_bit_cast(bf16x8, pfu);
                }
            }
#pragma unroll
            for (int s2 = 0; s2 < 2; ++s2)
#pragma unroll
                for (int db = 0; db < 2; ++db) {
                    const unsigned char* vrow = vbuf + (db * 32 + r) * 128 + 8 * hh;
                    const int c0 = 4 * kb + 2 * s2;
                    const bf16x4 v0 = *(const bf16x4*)(vrow + ((c0 ^ fsw) << 4)), v1 = *(const bf16x4*)(vrow + (((c0 + 1) ^ fsw) << 4));
                    const bf16x8 afv = __builtin_shufflevector(v0, v1, 0, 1, 2, 3, 4, 5, 6, 7);
                    O[0][db] = __builtin_amdgcn_mfma_f32_32x32x16_bf16(afv, pf[0][s2], O[0][db], 0, 0, 0);
                    O[1][db] = __builtin_amdgcn_mfma_f32_32x32x16_bf16(afv, pf[1][s2], O[1][db], 0, 0, 0);
                }
        }
    }
#pragma unroll
    for (int hq = 0; hq < 2; ++hq) {
        const int h = h0 + hq;
        float ls = lsum[hq];
        ls += __shfl_xor(ls, 32);
        ls += __builtin_amdgcn_exp2f(sinkv[hq] - mrun[hq]);
        const float inv = 1.f / ls;
#pragma unroll
        for (int db = 0; db < 2; ++db)
#pragma unroll
            for (int g = 0; g < 4; ++g) {
                const int dim = db * 32 + 8 * g + 4 * hh;
                const uint2 ga = *(const uint2*)(p.px + (size_t)qtok * PXW + PX_GA + h * 64 + dim);
                const float o0 = O[hq][db][4 * g + 0] * inv * lo_bf(ga.x), o1 = O[hq][db][4 * g + 1] * inv * hi_bf(ga.x);
                const float o2 = O[hq][db][4 * g + 2] * inv * lo_bf(ga.y), o3 = O[hq][db][4 * g + 3] * inv * hi_bf(ga.y);
                *(uint2*)(p.ycat + (size_t)qtok * LDK + h * 64 + dim) = make_uint2(cvtpk(o0, o1), cvtpk(o2, o3));
            }
    }
}

__device__ void conv_item(const Params& p, int l, int item, float* lds) {
    const int tid = opaque_tid(), lane = tid & 63, w = tid >> 6;
    int row0, len, t0;
    if (item < 512) { const int b = item >> 6; row0 = b * 2048; len = 2048; t0 = (item & 63) * 32; }
    else { const int q = item - 512, b = q >> 3; row0 = NTOK + b * 256; len = 256; t0 = (q & 7) * 32; }
    float wgt[31];
#pragma unroll
    for (int j = 0; j < 31; ++j) wgt[j] = p.conv_w[((size_t)l * 31 + j) * 256 + tid];
    const float cb = p.conv_b[l * 256 + tid];
    u32x4 av[8], gv[8];
#pragma unroll
    for (int q = 0; q < 8; ++q) {
        int id = tid + 256 * q; if (id > 62 * 32 - 1) id = 62 * 32 - 1;
        const int pp = id >> 5, c8 = (id & 31) * 8;
        int pos = t0 - 15 + pp; pos = pos < 0 ? 0 : (pos > len - 1 ? len - 1 : pos);
        const bf16_t* rp = p.px + (size_t)(row0 + pos) * PXW;
        av[q] = *(const u32x4*)(rp + PX_CA + c8); gv[q] = *(const u32x4*)(rp + PX_CB + c8);
    }
    __syncthreads();
#pragma unroll
    for (int q = 0; q < 8; ++q) {
        const int id = tid + 256 * q;
        const int pp = id >> 5, c8 = (id & 31) * 8;
        const int pos = t0 - 15 + pp;
        const float keep = (pos >= 0 && pos < len) ? 1.f : 0.f;
        float u[8];
#pragma unroll
        for (int e = 0; e < 4; ++e) { u[2 * e] = keep * lo_bf(av[q][e]) * sigm_f(lo_bf(gv[q][e])); u[2 * e + 1] = keep * hi_bf(av[q][e]) * sigm_f(hi_bf(gv[q][e])); }
        if (id < 62 * 32) {
            *(float4*)(lds + pp * 256 + c8) = make_float4(u[0], u[1], u[2], u[3]);
            *(float4*)(lds + pp * 256 + c8 + 4) = make_float4(u[4], u[5], u[6], u[7]);
        }
    }
    __syncthreads();
    float win[31];
#pragma unroll
    for (int j = 0; j < 31; ++j) win[j] = lds[j * 256 + tid];
#pragma unroll
    for (int tt = 0; tt < 32; ++tt) {
        float y0 = cb, y1 = 0.f;
#pragma unroll
        for (int j = 0; j < 30; j += 2) { y0 += wgt[j] * win[j]; y1 += wgt[j + 1] * win[j + 1]; }
        y0 += wgt[30] * win[30];
        const float nu = (tt < 31) ? lds[(tt + 31) * 256 + tid] : 0.f;
        lds[tt * 256 + tid] = y0 + y1;
#pragma unroll
        for (int j = 0; j < 30; ++j) win[j] = win[j + 1];
        win[30] = nu;
    }
    __syncthreads();
    const float4 lg = *(const float4*)(p.conv_ln_g + l * 256 + lane * 4), lb = *(const float4*)(p.conv_ln_b + l * 256 + lane * 4);
    uint2 gcv[8];
#pragma unroll
    for (int q = 0; q < 8; ++q) gcv[q] = *(const uint2*)(p.px + (size_t)(row0 + t0 + w * 8 + q) * PXW + PX_GC + lane * 4);
#pragma unroll
    for (int q = 0; q < 8; ++q) {
        const int t = w * 8 + q;
        const float4 v = *(const float4*)(lds + t * 256 + lane * 4);
        float s = v.x + v.y + v.z + v.w;
#pragma unroll
        for (int o = 32; o >= 1; o >>= 1) s += __shfl_xor(s, o);
        const float mu = s * (1.f / 256.f);
        const float d0 = v.x - mu, d1 = v.y - mu, d2 = v.z - mu, d3 = v.w - mu;
        float vs = d0 * d0 + d1 * d1 + d2 * d2 + d3 * d3;
#pragma unroll
        for (int o = 32; o >= 1; o >>= 1) vs += __shfl_xor(vs, o);
        const float rstd = rsqrtf(vs * (1.f / 256.f) + 1e-6f);
        const size_t tok = (size_t)(row0 + t0 + t);
        const uint2 gc = gcv[q];
        const float o0 = silu_f(d0 * rstd * lg.x + lb.x) * lo_bf(gc.x), o1 = silu_f(d1 * rstd * lg.y + lb.y) * hi_bf(gc.x);
        const float o2 = silu_f(d2 * rstd * lg.z + lb.z) * lo_bf(gc.y), o3 = silu_f(d3 * rstd * lg.w + lb.w) * hi_bf(gc.y);
        *(uint2*)(p.ycat + tok * LDK + 512 + lane * 4) = make_uint2(cvtpk(o0, o1), cvtpk(o2, o3));
    }
}

__device__ void final_item(const Params& p, int item) {
    const int tid = opaque_tid(), lane = tid & 63, w = tid >> 6;
    const int m0 = item * 8 + w * 2;
    float* row0 = p.out + (size_t)m0 * DM;
    float4 v[2][4];
#pragma unroll
    for (int rr = 0; rr < 2; ++rr)
#pragma unroll
        for (int i = 0; i < 4; ++i) v[rr][i] = *(const float4*)(row0 + rr * DM + i * 256 + lane * 4);
    float4 g[4];
#pragma unroll
    for (int i = 0; i < 4; ++i) g[i] = *(const float4*)(p.final_g + i * 256 + lane * 4);
#pragma unroll
    for (int rr = 0; rr < 2; ++rr) {
        float ss = 0.f;
#pragma unroll
        for (int i = 0; i < 4; ++i) ss += v[rr][i].x * v[rr][i].x + v[rr][i].y * v[rr][i].y + v[rr][i].z * v[rr][i].z + v[rr][i].w * v[rr][i].w;
#pragma unroll
        for (int o = 32; o >= 1; o >>= 1) ss += __shfl_xor(ss, o);
        const float rstd = rsqrtf(ss * (1.f / 1024.f) + 1e-6f);
#pragma unroll
        for (int i = 0; i < 4; ++i)
            *(float4*)(row0 + rr * DM + i * 256 + lane * 4) = make_float4(v[rr][i].x * rstd * g[i].x, v[rr][i].y * rstd * g[i].y, v[rr][i].z * rstd * g[i].z, v[rr][i].w * rstd * g[i].w);
    }
}

constexpr int N_PHASES = 10;
__device__ void mixer_phase(const Params& p, int l, unsigned char* lds) {
    const int G = gridDim.x, bid = blockIdx.x;
    const int NFx = l == 0 ? 18 : 16, NAx = l == 0 ? 72 : 64, NCx = l == 0 ? 72 : 64, NNx = l == 0 ? 64 : 32, NSx = l == 0 ? 22 : 0;
    const int NSM = NCx + NNx + NSx;
    const int x = bid & 7, S = G >> 3;
    for (int s = bid >> 3; s < 64; s += S) {
        const int i = s - NFx, R = 64 - NFx;
        const int nA = (s < NFx) ? 0 : ((i < NAx) ? (NAx - i + R - 1) / R : 0);
        for (int k = 0;; ++k) {
            int type, idx;
            if (s < NFx) {
                if (k == 0) { type = 0; idx = s < 16 ? x * 16 + s : 128 + x * 2 + (s - 16); }
                else if (k == 1) {
                    const int c = NSM - 1 - s;
                    const int q = c - NCx;
                    if (q < NNx) { type = 3; idx = q < 32 ? x * 32 + q : 256 + x * 32 + (q - 32); }
                    else { type = 4; idx = x * 22 + (q - NNx); }
                }
                else break;
            } else if (k < nA) {
                const int a = i + k * R;
                type = 1; idx = a < 64 ? x * 64 + a : 512 + x * 8 + (a - 64);
            } else {
                const int i0 = NAx - R, ks = k - nA;
                int c;
                if (i < i0) { if (ks > 0) break; c = i; }
                else c = i0 + (i - i0) + ks * (R - i0);
                if (c >= NSM - NFx) break;
                if (c < NCx) { type = 2; idx = c < 64 ? x * 64 + c : 512 + x * 8 + (c - 64); }
                else if (c < NCx + NNx) { const int q = c - NCx; type = 3; idx = q < 32 ? x * 32 + q : 256 + x * 32 + (q - 32); }
                else { type = 4; idx = x * 22 + (c - NCx - NNx); }
            }
            if (type == 0) fourier_tile(p, l, idx, lds);
            else if (type == 1) attn_item(p, l, idx, lds);
            else if (type == 2) conv_item(p, l, idx, (float*)lds);
            else if (type == 3) nyq_item(p, l, idx);
            else sw_item(p, idx);
        }
    }
}
DEV bool gemm_decode(int k, int nMx, int nN, int extra, int& mt, int& nt) {
    const int x = blockIdx.x & 7, S = gridDim.x >> 3, tl = (blockIdx.x >> 3) + k * S, tot = nMx * nN;
    if (tl < tot) { mt = (tl / nN) * 8 + x; nt = tl % nN; return true; }
    const int e = (tl - tot) * 8 + x;
    if (e < extra) { mt = 128 + (e >> 1); nt = (e & 1) ? 17 : 4; return true; }
    return false;
}
__device__ void run_phase(const Params& p, int ph, unsigned char* lds, int dup) {
    const int G = gridDim.x, bid = blockIdx.x;
    switch (ph) {
    case 0: phase0(p, lds); break;
    case 1:
        {
            float* tab = (float*)(lds + 57344);
            for (int i = threadIdx.x; i < 2048; i += 256) tab[i] = cospif((float)i * (1.f / 1024.f));
            __syncthreads();
        }
        {
            int kp = 0, kh = 0;
            for (int r = 0;; ++r) {
                const int ip = kp * G + bid, ih = kh * G + bid;
                const bool hp = ip < 256 + P1_PREP, hh_ = ih < 2304;
                if (!hp && !hh_) break;
                const bool do_h = hh_ && (!hp || ((r + bid + (bid >> 8)) & 1));
                if (do_h) { hx_item(p, 0, ih); ++kh; }
                else { if (ip < 256) fold_item(p, ip, (float*)lds); else phase1_prep(p, ip - 256, lds); ++kp; }
            }
        }
        break;
    case 2:
        { int mt, nt; for (int k = 0; gemm_decode(k, 18, 22, 0, mt, nt); ++k) inproj_tile(p, 0, mt, nt, lds); }
        break;
    case 3: mixer_phase(p, 0, lds); break;
    case 4:
        { int mt, nt; for (int k = 0; gemm_decode(k, 18, 8, 0, mt, nt); ++k) outproj_tile(p, 0, mt, nt, lds); }
        break;
    case 5:
        for (int it = bid; it < 2304; it += G) hx_item(p, 1, it);
        break;
    case 6:
        { int mt, nt; for (int k = 0; gemm_decode(k, 16, 22, 32, mt, nt); ++k) inproj_tile(p, 1, mt, nt, lds); }
        break;
    case 7: mixer_phase(p, 1, lds); break;
    case 8:
        { int mt, nt; for (int k = 0; gemm_decode(k, 16, 8, 0, mt, nt); ++k) outproj_tile(p, 1, mt, nt, lds); }
        break;
    case 9:
        for (int it = bid; it < 2048; it += G) final_item(p, it);
        break;
    }
}

__global__ void __launch_bounds__(256, 2) mega(Params p, int ph_lo, int ph_hi, int ph_dup) {
    __shared__ __attribute__((aligned(16))) unsigned char lds[LDS_BYTES];
#if MK_MULTI
    run_phase(p, ph_lo, lds);
#else
    XcdBarrier xb = xcd_barrier_post(p.bar);
    for (int ph = ph_lo; ph < ph_hi; ++ph) {
        if (ph == 5 || ph == 9) continue;
        const int reps = 1 + ((ph_dup >> ph) & 1);
        for (int r = 0; r < reps; ++r) {
            run_phase(p, ph, lds, ph_dup);
            if (r + 1 < reps) xcd_barrier(xb);
        }
        if (ph + 1 < ph_hi) {
            if (ph_lo < 0) cg::this_grid().sync();
            xcd_barrier(xb);
        }
    }
#endif
}

extern "C" void kernel_launch(void* const* d_in, const int* in_sizes, int n_in, void* d_out, int out_size, void* d_ws, size_t ws_size, hipStream_t stream) {
    Params p{};
    p.x = (const float*)d_in[0]; p.c = (const float*)d_in[1]; p.ctx = (const float*)d_in[2]; p.c_ctx = (const float*)d_in[3];
    p.w_ada = (const float*)d_in[4]; p.b_ada = (const float*)d_in[5]; p.norm_g = (const float*)d_in[6]; p.w_in = (const float*)d_in[7];
    p.attn_sink = (const float*)d_in[8]; p.conv_w = (const float*)d_in[9]; p.conv_b = (const float*)d_in[10]; p.conv_ln_g = (const float*)d_in[11];
    p.conv_ln_b = (const float*)d_in[12]; p.w_four = (const float*)d_in[13]; p.b_four = (const float*)d_in[14]; p.w_out = (const float*)d_in[15];
    p.final_g = (const float*)d_in[16];
    p.out = (float*)d_out;
    unsigned char* ws = (unsigned char*)d_ws;
    size_t off = 0;
    auto take = [&](size_t bytes) { unsigned char* r = ws + off; off += (bytes + 255) & ~(size_t)255; return r; };
    p.bar = (unsigned*)take(XCD_BAR_WORDS * 4);
    p.mod = (float*)take(2 * 9 * 3072 * 4);
    p.rowss = (float*)take((size_t)MTOT * 4);
    p.rowss2 = (float*)take((size_t)NTOK * 4);
    p.pcnt = (unsigned*)take((size_t)128 * 16 * 4);
    p.rope = (float*)take(96 * 16 * 2 * 4);
    p.wc = (float*)take(2 * 2 * 256 * 256 * 4);
    p.winT = (bf16_t*)take((size_t)2 * NINP * LDK * 2);
    p.woutT = (bf16_t*)take((size_t)2 * 1024 * LDK * 2);
    p.dft = (bf16_t*)take((size_t)2048 * LDF * 2);
    p.dftc = (bf16_t*)take((size_t)256 * 512 * 2);
    p.hx = (bf16_t*)take((size_t)MTOT * LDK * 2);
    p.px = (bf16_t*)take((size_t)MTOT * PXW * 2);
    p.vtl = (bf16_t*)take((size_t)8 * 128 * LDV * 2);
    p.vtc = (bf16_t*)take((size_t)8 * 128 * 256 * 2);
    p.fbl = (bf16_t*)take((size_t)8 * 256 * LDF * 2);
    p.fbc = (bf16_t*)take((size_t)8 * 256 * 512 * 2);
    p.ycat = (bf16_t*)take((size_t)MTOT * LDK * 2);
    p.x1c = (float*)take((size_t)NCTXT * 1024 * 4);
    p.fscr = (float*)take((size_t)512 * 16384 * 4);
    p.sw = (float*)take((size_t)9 * NINP * 4);
    if (off > ws_size) { fprintf(stderr, "workspace too small: need %zu have %zu\n", off, ws_size); return; }
#if MK_MULTI
    for (int ph = 0; ph < N_PHASES; ++ph) mega<<<dim3(1024), dim3(256), 0, stream>>>(p, ph, ph + 1);
#else
    static int grid_blocks = 0;
    if (!grid_blocks) {
        int dev = 0, cus = 0, per_cu = 0;
        hipGetDevice(&dev);
        hipDeviceGetAttribute(&cus, hipDeviceAttributeMultiprocessorCount, dev);
        hipOccupancyMaxActiveBlocksPerMultiprocessor(&per_cu, mega, 256, 0);
        if (per_cu > 2) per_cu = 2;
        grid_blocks = (cus * per_cu) & ~7;
        if (grid_blocks > 512) grid_blocks = 512;
        if (grid_blocks < 8) grid_blocks = 8;
    }
    (void)hipMemsetAsync(p.bar, 0, (size_t)((unsigned char*)p.pcnt - (unsigned char*)p.bar) + (size_t)128 * 16 * 4, stream);
#ifndef PH_DUP
#define PH_DUP 0
#endif
    int lo = 0, hi = 9, dup = PH_DUP;
    void* args[] = {&p, &lo, &hi, &dup};
    hipError_t e = hipLaunchCooperativeKernel((void*)mega, dim3(grid_blocks), dim3(256), args, 0, stream);
    if (e != hipSuccess) fprintf(stderr, "cooperative launch failed: %s (grid %d)\n", hipGetErrorString(e), grid_blocks);
#endif
}
```

```cpp
#include <hip/hip_runtime.h>
#include <hip/hip_cooperative_groups.h>
#include <cstdio>
#include <cstdint>
namespace cg = cooperative_groups;

#ifndef MK_MULTI
#define MK_MULTI 0
#endif

typedef unsigned short bf16_t;
typedef short bf16x8 __attribute__((ext_vector_type(8)));
typedef short bf16x4 __attribute__((ext_vector_type(4)));
typedef float f32x4 __attribute__((ext_vector_type(4)));
typedef float f32x16 __attribute__((ext_vector_type(16)));
typedef unsigned u32x4 __attribute__((ext_vector_type(4)));
typedef unsigned u32x2 __attribute__((ext_vector_type(2)));
#define DEV __device__ __forceinline__

constexpr int NTOK = 16384, NCTXT = 2048, MTOT = 18432, DM = 1024;
constexpr int LDK = 1088, LDF = 4160, LDV = 2112;
constexpr int PXW = 2176;
constexpr int PX_Q = 0, PX_K = 512, PX_GA = 640, PX_CA = 1152, PX_CB = 1408, PX_GC = 1664, PX_GF = 1920;
constexpr int NINP = 2816;
constexpr int LDS_BYTES = 65536;

struct Params {
    const float *x, *c, *ctx, *c_ctx, *w_ada, *b_ada, *norm_g, *w_in, *attn_sink, *conv_w, *conv_b, *conv_ln_g, *conv_ln_b,
        *w_four, *b_four, *w_out, *final_g;
    float* out;
    unsigned* bar;
    float* mod;
    float* rope;
    float* wc;
    bf16_t* winT;
    bf16_t* woutT;
    bf16_t* dft;
    bf16_t* dftc;
    bf16_t* hx;
    bf16_t* px;
    bf16_t* vtl;
    bf16_t* vtc;
    bf16_t* fbl;
    bf16_t* fbc;
    bf16_t* ycat;
    float* x1c;
    float* fscr;
    float* rowss;
    float* rowss2;
    unsigned* pcnt;
    float* sw;
};

DEV float bf2f(bf16_t v) { return __uint_as_float(((unsigned)v) << 16); }
typedef __bf16 bf16v2 __attribute__((ext_vector_type(2)));
typedef float f32v2 __attribute__((ext_vector_type(2)));
DEV unsigned cvtpk(float lo, float hi) { f32v2 v = {lo, hi}; bf16v2 b = __builtin_convertvector(v, bf16v2); return __builtin_bit_cast(unsigned, b); }
DEV float silu_f(float v) { return v * __builtin_amdgcn_rcpf(1.f + __expf(-v)); }
DEV float sigm_f(float v) { return __builtin_amdgcn_rcpf(1.f + __expf(-v)); }
DEV int opaque_tid() { int t = threadIdx.x; asm volatile("" : "+v"(t)); return t; }
DEV float lo_bf(unsigned u) { return __uint_as_float(u << 16); }
DEV float hi_bf(unsigned u) { return __uint_as_float(u & 0xffff0000u); }

#define XB_TMO      128
#define XB_XCNT(j)  (256  + 64 * (j))
#define XB_XSUB(j)  (1280 + 64 * (j))
#define XB_XGEN(j)  (2304 + 64 * (j))
#define XB_TOP      3328
#define XB_TOPGEN   3392
#define XCD_BAR_WORDS 3456
#define XB_SPIN_CAP (1u << 22)
#define LAS __attribute__((address_space(3)))
DEV unsigned xb_ld(unsigned* p) { return __hip_atomic_load(p, __ATOMIC_RELAXED, __HIP_MEMORY_SCOPE_AGENT); }
DEV unsigned xb_add(unsigned* p, unsigned v) { return __hip_atomic_fetch_add(p, v, __ATOMIC_RELAXED, __HIP_MEMORY_SCOPE_AGENT); }
DEV unsigned xb_xcc_id() { return (unsigned)__builtin_amdgcn_s_getreg((3 << 11) | 20) & 0xFu; }
#define XB_SPIN(cond, bar) do { unsigned _sp = 0; while (cond) { __builtin_amdgcn_s_sleep(1); \
    if ((++_sp & 255u) == 0u) { if (xb_ld(&(bar)[XB_TMO])) break; if (_sp > XB_SPIN_CAP) { atomicAdd(&(bar)[XB_TMO], 1u); break; } } } } while (0)
struct XcdBarrier { unsigned* bar; unsigned x; unsigned nloc, nx; };
DEV XcdBarrier xcd_barrier_post(unsigned* bar) {
    XcdBarrier b; b.bar = bar; b.x = xb_xcc_id(); b.nloc = 0u; b.nx = 0u;
    if (threadIdx.x == 0) (void)xb_add(&bar[XB_XCNT(b.x)], 1u);
    return b;
}
DEV void xcd_barrier_complete(unsigned* bar, unsigned x, unsigned& nloc, unsigned& nx) {
    const unsigned G = gridDim.x * gridDim.y * gridDim.z;
    unsigned sum, cnt, mine, sp = 0u;
    for (;;) {
        sum = 0u; cnt = 0u; mine = 0u;
#pragma unroll
        for (unsigned j = 0; j < 16; ++j) { const unsigned c = xb_ld(&bar[XB_XCNT(j)]); sum += c; cnt += (c > 0u) ? 1u : 0u; mine = (j == x) ? c : mine; }
        if (sum == G) break;
        __builtin_amdgcn_s_sleep(1);
        if ((++sp & 255u) == 0u) { if (xb_ld(&bar[XB_TMO])) break; if (sp > XB_SPIN_CAP) { atomicAdd(&bar[XB_TMO], 1u); break; } }
    }
    nloc = mine > 0u ? mine : 1u; nx = cnt > 0u ? cnt : 1u;
}
DEV void xcd_barrier(XcdBarrier& b) {
    asm volatile("s_waitcnt vmcnt(0)" ::: "memory");
    __syncthreads();
    if (threadIdx.x == 0) {
        unsigned* bar = b.bar;
        __builtin_amdgcn_s_waitcnt(0);
        unsigned nloc = b.nloc, nx = b.nx;
        if (nloc == 0u) { xcd_barrier_complete(bar, b.x, nloc, nx); b.nloc = nloc; b.nx = nx; }
        const unsigned old = xb_add(&bar[XB_XSUB(b.x)], 1u);
        const unsigned gen = old / nloc;
        if (old + 1u == (gen + 1u) * nloc) {
            __builtin_amdgcn_fence(__ATOMIC_RELEASE, "agent");
            asm volatile("s_waitcnt vmcnt(0)" ::: "memory");
            const unsigned og = xb_add(&bar[XB_TOP], 1u);
            const unsigned tg = og / nx;
            if (og + 1u == (tg + 1u) * nx) xb_add(&bar[XB_TOPGEN], 1u);
            else XB_SPIN(xb_ld(&bar[XB_TOPGEN]) == tg, bar);
            __builtin_amdgcn_fence(__ATOMIC_ACQUIRE, "agent");
            xb_add(&bar[XB_XGEN(b.x)], 1u);
            asm volatile("s_waitcnt vmcnt(0)" ::: "memory");
        } else {
            XB_SPIN(xb_ld(&bar[XB_XGEN(b.x)]) == gen, bar);
            __builtin_amdgcn_fence(__ATOMIC_ACQUIRE, "agent");
            asm volatile("s_waitcnt vmcnt(0)" ::: "memory");
        }
    }
    __syncthreads();
}

__device__ void ada_item(const Params& p, int item, float* lds) {
    const int tid = opaque_tid();
    const int l = item / 192, r = item % 192, kc = r / 12, jc = r % 12;
    const int k0 = kc * 64, j = jc * 256 + tid;
    __syncthreads();
#pragma unroll
    for (int q = 0; q < 3; ++q) {
        const int idx = tid + 256 * q;
        if (idx < 576) {
            const int b = idx >> 6, kk = idx & 63;
            const float v = (b < 8) ? p.c[b * 1024 + k0 + kk] : p.c_ctx[k0 + kk];
            lds[idx] = v * __builtin_amdgcn_rcpf(1.f + __expf(-v));
        }
    }
    __syncthreads();
    float acc[9];
#pragma unroll
    for (int b = 0; b < 9; ++b) acc[b] = 0.f;
    const float* wp = p.w_ada + (size_t)l * 1024 * 3072 + (size_t)k0 * 3072 + j;
#pragma unroll 32
    for (int kk = 0; kk < 64; ++kk) {
        const float wv = wp[(size_t)kk * 3072];
#pragma unroll
        for (int b = 0; b < 9; ++b) acc[b] += lds[b * 64 + kk] * wv;
    }
    const float bias = (kc == 0) ? p.b_ada[l * 3072 + j] : 0.f;
#pragma unroll
    for (int b = 0; b < 9; ++b) atomicAdd(p.mod + ((size_t)l * 9 + b) * 3072 + j, acc[b] + bias);
}

__device__ void wc_item(const Params& p, int item, const float* tab) {
    const int tid = opaque_tid(), lane = tid & 63, w = tid >> 6, li = lane & 31, kk = lane >> 5;
    const int jq = item & 1, ct = (item >> 1) & 1, h = (item >> 2) & 3, part = (item >> 4) & 1, l = item >> 5;
    const int cc = ct * 32 + li, j0 = jq * 128 + w * 32;
    const int ph = part ? 1536 : 0;
    const float* wf = p.w_four + (size_t)l * 65536 + (size_t)(h * 64 + kk) * 256 + j0 + li;
    f32x16 acc;
#pragma unroll
    for (int e = 0; e < 16; ++e) acc[e] = 0.f;
#pragma unroll 8
    for (int t = 0; t < 32; ++t) {
        const int m = 2 * t + kk;
        acc = __builtin_amdgcn_mfma_f32_32x32x2f32(tab[(32 * cc * m + ph) & 2047], wf[(2 * t) * 256], acc, 0, 0, 0);
    }
    float* op = p.wc + ((size_t)(l * 2 + part) * 256 + h * 64 + ct * 32 + 4 * kk) * 256 + j0 + li;
#pragma unroll
    for (int e = 0; e < 16; ++e) op[((e & 3) + 8 * (e >> 2)) * 256] = acc[e] * 0.125f;
}

__device__ void transpose_tile(const float* src, int sld, bf16_t* dst, int dld, float* t) {
    const int tid = opaque_tid();
    __syncthreads();
#pragma unroll
    for (int i = 0; i < 4; ++i) {
        const int id = tid + 256 * i, k = id >> 4, c = id & 15;
        const float4 v = *(const float4*)(src + (size_t)k * sld + c * 4);
        t[k * 65 + c * 4 + 0] = v.x; t[k * 65 + c * 4 + 1] = v.y; t[k * 65 + c * 4 + 2] = v.z; t[k * 65 + c * 4 + 3] = v.w;
    }
    __syncthreads();
    const int n = tid >> 2, kq = tid & 3;
    unsigned o[8];
#pragma unroll
    for (int e = 0; e < 8; ++e) o[e] = cvtpk(t[(kq * 16 + 2 * e) * 65 + n], t[(kq * 16 + 2 * e + 1) * 65 + n]);
    uint4* d = (uint4*)(dst + (size_t)n * dld + kq * 16);
    d[0] = make_uint4(o[0], o[1], o[2], o[3]);
    d[1] = make_uint4(o[4], o[5], o[6], o[7]);
}

DEV int win_dst_row(int n) {
    if (n < 640) return n;
    if (n < 768) return 2176 + (n - 640);
    if (n < 1280) return 640 + (n - 768);
    if (n < 1536) return 1152 + (n - 1280);
    if (n < 1792) return 1408 + (n - 1536);
    if (n < 2048) return 1664 + (n - 1792);
    return 1920 + (n - 2304);
}

__device__ void dft_item(const Params& p, int item, const float* tab) {
    const int tid = opaque_tid();
#pragma unroll
    for (int q = 0; q < 4; ++q) {
        const int idx = ((item * 4 + q) * 256 + tid) * 8;
        const int k = idx >> 12, n0 = idx & 4095;
        const int ph = (n0 < 2048) ? 0 : 512;
        unsigned o[4];
#pragma unroll
        for (int e = 0; e < 4; ++e) {
            const int n = (n0 + 2 * e) & 2047;
            o[e] = cvtpk(tab[(k * n + ph) & 2047], tab[(k * (n + 1) + ph) & 2047]);
        }
        *(uint4*)(p.dft + (size_t)k * LDF + n0) = make_uint4(o[0], o[1], o[2], o[3]);
    }
}
__device__ void dftc_item(const Params& p, int item, const float* tab) {
    const int idx = (item * 256 + opaque_tid()) * 8;
    const int k = idx >> 9, n0 = idx & 511;
    const int ph = (n0 < 256) ? 0 : 512;
    unsigned o[4];
#pragma unroll
    for (int e = 0; e < 4; ++e) {
        const int n = (n0 + 2 * e) & 255;
        o[e] = cvtpk(tab[(8 * k * n + ph) & 2047], tab[(8 * k * (n + 1) + ph) & 2047]);
    }
    *(uint4*)(p.dftc + idx) = make_uint4(o[0], o[1], o[2], o[3]);
}
__device__ void rope_item(const Params& p) {
    for (int i = threadIdx.x; i < 96 * 16; i += 256) {
        const int pp = i >> 4, f = i & 15;
        const float pos = (float)(pp < 32 ? pp : pp - 32);
        const float freq = powf(10000.f, -(float)f / 16.f);
        const float ang = pos * freq;
        p.rope[i * 2] = cosf(ang); p.rope[i * 2 + 1] = sinf(ang);
    }
}

__device__ void phase0(const Params& p, unsigned char* lds) {
    constexpr int N_ADA = 384, N_WC = 64;
    float* tab = (float*)(lds + 57344);
    for (int i = threadIdx.x; i < 2048; i += 256) tab[i] = cospif((float)i * (1.f / 1024.f));
    __syncthreads();
    for (int it = blockIdx.x; it < N_ADA + N_WC; it += gridDim.x) {
        if (it < N_WC) wc_item(p, it, tab);
        else ada_item(p, it - N_WC, (float*)lds);
    }
}
__device__ void phase1_prep(const Params& p, int it, unsigned char* lds) {
    constexpr int O3 = 1152, O4 = O3 + 512, O5 = O4 + 1024, O6 = O5 + 64;
    const float* tab = (const float*)(lds + 57344);
    if (it < O3) {
        const int q = it, l = q / 576, r = q % 576, ct = r >> 4, kt = r & 15;
        const int n0 = ct < 32 ? ct * 64 : 2304 + (ct - 32) * 64;
        transpose_tile(p.w_in + (size_t)l * 1024 * 2560 + (size_t)(kt * 64) * 2560 + n0, 2560,
                       p.winT + (size_t)l * NINP * LDK + (size_t)win_dst_row(n0) * LDK + kt * 64, LDK, (float*)lds);
    } else if (it < O4) {
        const int q = it - O3, l = q >> 8, r = q & 255, ct = r >> 4, kt = r & 15;
        transpose_tile(p.w_out + (size_t)l * 1048576 + (size_t)(kt * 64) * 1024 + ct * 64, 1024,
                       p.woutT + (size_t)l * 1024 * LDK + (size_t)(ct * 64) * LDK + kt * 64, LDK, (float*)lds);
    } else if (it < O5) dft_item(p, it - O4, tab);
    else if (it < O6) dftc_item(p, it - O5, tab);
    else rope_item(p);
}
constexpr int P1_PREP = 1152 + 512 + 1024 + 64 + 1;

__device__ void fold_item(const Params& p, int item, float* lds) {
    const int tid = opaque_tid(), lane = tid & 63, w = tid >> 6, wr = w >> 1, wc = w & 1, li = lane & 31, kk = lane >> 5;
    const int l = item >> 7, part = (item >> 6) & 1, kt = (item >> 2) & 15, jt = item & 3;
    const int k0 = kt * 64 + wr * 32, j0 = jt * 64 + wc * 32;
    const float* ap = p.w_in + (size_t)l * 1024 * 2560 + (size_t)(k0 + li) * 2560 + 2048 + 4 * kk;
    const float* bp = p.wc + ((size_t)(l * 2 + part) * 256 + 4 * kk) * 256 + j0 + li;
    f32x16 acc;
#pragma unroll
    for (int e = 0; e < 16; ++e) acc[e] = 0.f;
#pragma unroll 4
    for (int u = 0; u < 32; ++u) {
        const float4 a = *(const float4*)(ap + 8 * u);
        const float b0 = bp[(8 * u + 0) * 256], b1 = bp[(8 * u + 1) * 256], b2 = bp[(8 * u + 2) * 256], b3 = bp[(8 * u + 3) * 256];
        acc = __builtin_amdgcn_mfma_f32_32x32x2f32(a.x, b0, acc, 0, 0, 0);
        acc = __builtin_amdgcn_mfma_f32_32x32x2f32(a.y, b1, acc, 0, 0, 0);
        acc = __builtin_amdgcn_mfma_f32_32x32x2f32(a.z, b2, acc, 0, 0, 0);
        acc = __builtin_amdgcn_mfma_f32_32x32x2f32(a.w, b3, acc, 0, 0, 0);
    }
    bf16_t* op = p.winT + (size_t)l * NINP * LDK + (size_t)(2304 + part * 256 + j0 + li) * LDK + k0 + 4 * kk;
#pragma unroll
    for (int g = 0; g < 4; ++g)
        *(uint2*)(op + 8 * g) = make_uint2(cvtpk(acc[4 * g + 0], acc[4 * g + 1]), cvtpk(acc[4 * g + 2], acc[4 * g + 3]));
}

__device__ void hx_item(const Params& p, int l, int item) {
    const int tid = opaque_tid(), lane = tid & 63, w = tid >> 6;
    const int m0 = item * 8 + w * 2;
    const float* src0;
    if (l == 0) src0 = (m0 < NTOK) ? p.x + (size_t)m0 * DM : p.ctx + (size_t)(m0 - NTOK) * DM;
    else src0 = (m0 < NTOK) ? p.out + (size_t)m0 * DM : p.x1c + (size_t)(m0 - NTOK) * DM;
    const int b = (m0 < NTOK) ? (m0 >> 11) : 8;
    float4 v[2][4];
#pragma unroll
    for (int rr = 0; rr < 2; ++rr)
#pragma unroll
        for (int i = 0; i < 4; ++i) v[rr][i] = *(const float4*)(src0 + rr * DM + i * 256 + lane * 4);
    const float* g = p.norm_g + l * DM;
    const float* sh = p.mod + ((size_t)l * 9 + b) * 3072;
    const float* sc = sh + 1024;
    float4 gm[4], hm[4];
#pragma unroll
    for (int i = 0; i < 4; ++i) {
        const int col = i * 256 + lane * 4;
        const float4 gg = *(const float4*)(g + col), s4 = *(const float4*)(sc + col);
        hm[i] = *(const float4*)(sh + col);
        gm[i] = make_float4(gg.x * (1.f + s4.x), gg.y * (1.f + s4.y), gg.z * (1.f + s4.z), gg.w * (1.f + s4.w));
    }
#pragma unroll
    for (int rr = 0; rr < 2; ++rr) {
        float ss = 0.f;
#pragma unroll
        for (int i = 0; i < 4; ++i) ss += v[rr][i].x * v[rr][i].x + v[rr][i].y * v[rr][i].y + v[rr][i].z * v[rr][i].z + v[rr][i].w * v[rr][i].w;
#pragma unroll
        for (int o = 32; o >= 1; o >>= 1) ss += __shfl_xor(ss, o);
        const float rstd = rsqrtf(ss * (1.f / 1024.f) + 1e-6f);
#pragma unroll
        for (int i = 0; i < 4; ++i) {
            const int col = i * 256 + lane * 4;
            const float a0 = v[rr][i].x * rstd * gm[i].x + hm[i].x;
            const float a1 = v[rr][i].y * rstd * gm[i].y + hm[i].y;
            const float a2 = v[rr][i].z * rstd * gm[i].z + hm[i].z;
            const float a3 = v[rr][i].w * rstd * gm[i].w + hm[i].w;
            *(uint2*)(p.hx + (size_t)(m0 + rr) * LDK + col) = make_uint2(cvtpk(a0, a1), cvtpk(a2, a3));
        }
    }
}

template <bool SWAP>
DEV void gemm_core(const bf16_t* __restrict__ A, int lda, const bf16_t* __restrict__ Bt, int ldb, int K, unsigned char* lds, f32x4 (&acc)[4][4]) {
    const int tid = opaque_tid(), lane = tid & 63, w = tid >> 6, wr = w >> 1, wc = w & 1;
    const int fr = lane & 15, fq = lane >> 4;
    const int srow = tid >> 3, sc = (tid & 7) ^ ((srow >> 1) & 7);
    const bf16_t* ga = A + (size_t)srow * lda + sc * 8;
    const bf16_t* gb = Bt + (size_t)srow * ldb + sc * 8;
    unsigned char* la = lds + __builtin_amdgcn_readfirstlane(tid >> 6) * 1024;
#define GEMM_STAGE(buf, kt) do { \
        _Pragma("unroll") for (int _i = 0; _i < 4; ++_i) { \
            __builtin_amdgcn_global_load_lds((const unsigned*)(ga + (size_t)(32 * _i) * lda + (kt) * 64), (unsigned*)(la + (buf) * 32768 + _i * 4096), 16, 0, 0); \
            __builtin_amdgcn_global_load_lds((const unsigned*)(gb + (size_t)(32 * _i) * ldb + (kt) * 64), (unsigned*)(la + (buf) * 32768 + 16384 + _i * 4096), 16, 0, 0); \
        } } while (0)
#pragma unroll
    for (int i = 0; i < 4; ++i)
#pragma unroll
        for (int j = 0; j < 4; ++j) acc[i][j] = (f32x4){0.f, 0.f, 0.f, 0.f};
    const int nk = K >> 6;
    const int po0 = (fq ^ (fr >> 1)) * 16, po1 = ((4 + fq) ^ (fr >> 1)) * 16;
    const unsigned char* fa = lds + (wr * 64 + fr) * 128;
    const unsigned char* fb = lds + 16384 + (wc * 64 + fr) * 128;
    __syncthreads();
    GEMM_STAGE(0, 0);
    for (int kt = 0; kt < nk; ++kt) {
        asm volatile("s_waitcnt vmcnt(0)" ::: "memory");
        __syncthreads();
        const int buf = kt & 1;
        if (kt + 1 < nk) GEMM_STAGE(buf ^ 1, kt + 1);
        bf16x8 af[2][4], bfr[2][4];
#pragma unroll
        for (int ks = 0; ks < 2; ++ks) {
            const int po = ks ? po1 : po0;
            bfr[ks][0] = *(const bf16x8*)(fb + buf * 32768 + 0 * 2048 + po);
            af[ks][0] = *(const bf16x8*)(fa + buf * 32768 + 0 * 2048 + po);
#pragma unroll
            for (int j = 1; j < 4; ++j) bfr[ks][j] = *(const bf16x8*)(fb + buf * 32768 + j * 2048 + po);
#pragma unroll
            for (int i = 1; i < 4; ++i) af[ks][i] = *(const bf16x8*)(fa + buf * 32768 + i * 2048 + po);
        }
#pragma unroll
        for (int ks = 0; ks < 2; ++ks)
#pragma unroll
            for (int i = 0; i < 4; ++i)
#pragma unroll
                for (int j = 0; j < 4; ++j) {
                    if (SWAP) acc[i][j] = __builtin_amdgcn_mfma_f32_16x16x32_bf16(bfr[ks][j], af[ks][i], acc[i][j], 0, 0, 0);
                    else      acc[i][j] = __builtin_amdgcn_mfma_f32_16x16x32_bf16(af[ks][i], bfr[ks][j], acc[i][j], 0, 0, 0);
                }
        __builtin_amdgcn_sched_group_barrier(0x100, 5, 0);
#pragma unroll
        for (int q = 0; q < 11; ++q) { __builtin_amdgcn_sched_group_barrier(0x008, 1, 0); __builtin_amdgcn_sched_group_barrier(0x100, 1, 0); }
        __builtin_amdgcn_sched_group_barrier(0x008, 21, 0);
    }
#undef GEMM_STAGE
}

__device__ void inproj_tile(const Params& p, int l, int mt, int nt, unsigned char* lds) {
    const int tid = opaque_tid(), lane = tid & 63, w = tid >> 6, wr = w >> 1, wc = w & 1, fr = lane & 15, fq = lane >> 4;
    const bf16_t* A = p.hx + (size_t)(mt * 128) * LDK;
    const bf16_t* Bt = p.winT + (size_t)l * NINP * LDK + (size_t)(nt * 128) * LDK;
    f32x4 acc[4][4];
    const bool latent = mt < 128;
    const int bb = latent ? (mt >> 4) : 8;
    if (nt < 17) {
        f32x4 bias[4]; float rss[4];
        if (l == 1) {
#pragma unroll
            for (int j = 0; j < 4; ++j) bias[j] = *(const f32x4*)(p.sw + (size_t)bb * NINP + nt * 128 + wc * 64 + j * 16 + fq * 4);
#pragma unroll
            for (int i = 0; i < 4; ++i) rss[i] = p.rowss[mt * 128 + wr * 64 + i * 16 + fr];
        }
        gemm_core<true>(A, LDK, Bt, LDK, 1024, lds, acc);
        if (l == 1) {
#pragma unroll
            for (int i = 0; i < 4; ++i) {
                const float rstd = rsqrtf(rss[i] * (1.f / 1024.f) + 1e-6f);
#pragma unroll
                for (int j = 0; j < 4; ++j) acc[i][j] = acc[i][j] * rstd + bias[j];
            }
        }
        const bool isq = nt < 4, isk = nt == 4;
        const bool gated = (nt >= 5 && nt <= 8) || (nt >= 13);
#pragma unroll
        for (int i = 0; i < 4; ++i) {
            const int m = mt * 128 + wr * 64 + i * 16 + fr;
            if ((isq || isk) && latent) {
                const int t = m & 2047, rp = t >> 6, cp = 32 + (t & 63);
                const float4* r1 = (const float4*)(p.rope + (rp * 16 + fq * 4) * 2);
                const float4* r2 = (const float4*)(p.rope + (cp * 16 + fq * 4) * 2);
                const float4 ra0 = r1[0], ra1 = r1[1], rb0 = r2[0], rb1 = r2[1];
                const float cr[4] = {ra0.x, ra0.z, ra1.x, ra1.z}, sr[4] = {ra0.y, ra0.w, ra1.y, ra1.w};
                const float cc[4] = {rb0.x, rb0.z, rb1.x, rb1.z}, sc[4] = {rb0.y, rb0.w, rb1.y, rb1.w};
#pragma unroll
                for (int e = 0; e < 4; ++e) {
                    const float x1 = acc[i][0][e], x2 = acc[i][1][e];
                    acc[i][0][e] = x1 * cr[e] - x2 * sr[e]; acc[i][1][e] = x1 * sr[e] + x2 * cr[e];
                    const float y1 = acc[i][2][e], y2 = acc[i][3][e];
                    acc[i][2][e] = y1 * cc[e] - y2 * sc[e]; acc[i][3][e] = y1 * sc[e] + y2 * cc[e];
                }
            }
            bf16_t* orow = p.px + (size_t)m * PXW + nt * 128 + wc * 64 + fq * 4;
#pragma unroll
            for (int j = 0; j < 4; ++j) {
                f32x4 v = acc[i][j];
                if (isq) v = v * 0.18033688011112042f;
                if (gated) { v[0] = silu_f(v[0]); v[1] = silu_f(v[1]); v[2] = silu_f(v[2]); v[3] = silu_f(v[3]); }
                *(uint2*)(orow + j * 16) = make_uint2(cvtpk(v[0], v[1]), cvtpk(v[2], v[3]));
            }
        }
    } else {
        gemm_core<false>(A, LDK, Bt, LDK, 1024, lds, acc);
        if (l == 1) {
            float bias[4];
#pragma unroll
            for (int j = 0; j < 4; ++j) bias[j] = p.sw[(size_t)bb * NINP + nt * 128 + wc * 64 + j * 16 + fr];
#pragma unroll
            for (int i = 0; i < 4; ++i) {
                const float4 ss = *(const float4*)(p.rowss + mt * 128 + wr * 64 + i * 16 + fq * 4);
                const f32x4 rs = {rsqrtf(ss.x * (1.f / 1024.f) + 1e-6f), rsqrtf(ss.y * (1.f / 1024.f) + 1e-6f), rsqrtf(ss.z * (1.f / 1024.f) + 1e-6f), rsqrtf(ss.w * (1.f / 1024.f) + 1e-6f)};
#pragma unroll
                for (int j = 0; j < 4; ++j) acc[i][j] = acc[i][j] * rs + bias[j];
            }
        }
        int b, t0, T;
        if (latent) { b = mt >> 4; t0 = (mt & 15) * 128; T = 2048; }
        else { const int q = mt - 128; b = q >> 1; t0 = (q & 1) * 128; T = 256; }
        bf16_t* base; size_t ld;
        if (nt == 17) { ld = latent ? LDV : 256; base = (latent ? p.vtl : p.vtc) + (size_t)(b * 128) * ld; }
        else {
            const int part = (nt >= 20), jb = ((nt - 18) & 1) * 128;
            ld = latent ? LDF : 512;
            base = (latent ? p.fbl : p.fbc) + ((size_t)(b * 256 + jb)) * ld + part * T;
        }
#pragma unroll
        for (int i = 0; i < 4; ++i) {
            const int t = t0 + wr * 64 + i * 16 + fq * 4;
#pragma unroll
            for (int j = 0; j < 4; ++j) {
                const int n = wc * 64 + j * 16 + fr;
                const f32x4 v = acc[i][j];
                *(uint2*)(base + (size_t)n * ld + t) = make_uint2(cvtpk(v[0], v[1]), cvtpk(v[2], v[3]));
            }
        }
    }
}

__device__ void fourier_tile(const Params& p, int l, int it, unsigned char* lds) {
    const int tid = opaque_tid(), lane = tid & 63, w = tid >> 6, wr = w >> 1, wc = w & 1, fr = lane & 15, fq = lane >> 4;
    const bf16_t *A, *Bt; int ld, N, tok0, k0, nt; float scale;
    if (it < 128) {
        const int b = it >> 4, kt = (it >> 1) & 7; nt = it & 1;
        A = p.dft + (size_t)(kt * 128) * LDF; Bt = p.fbl + (size_t)(b * 256 + nt * 128) * LDF; ld = LDF; N = 2048;
        tok0 = b * 2048; k0 = kt * 128; scale = 0.022097086912079608f;
    } else {
        const int q = it - 128, b = q >> 1; nt = q & 1;
        A = p.dftc; Bt = p.fbc + (size_t)(b * 256 + nt * 128) * 512; ld = 512; N = 256;
        tok0 = NTOK + b * 256; k0 = 0; scale = 0.0625f;
    }
    f32x4 accP[4][4], accQ[4][4];
    f32x4* scr = (f32x4*)(p.fscr + (size_t)blockIdx.x * 16384) + tid;
    gemm_core<true>(A, ld, Bt, ld, N, lds, accQ);
#pragma unroll
    for (int i = 0; i < 4; ++i)
#pragma unroll
        for (int j = 0; j < 4; ++j) scr[(i * 4 + j) * 256] = accQ[i][j];
    gemm_core<true>(A + N, ld, Bt + N, ld, N, lds, accQ);
#pragma unroll
    for (int i = 0; i < 4; ++i)
#pragma unroll
        for (int j = 0; j < 4; ++j) accP[i][j] = scr[(i * 4 + j) * 256];
#pragma unroll
    for (int i = 0; i < 4; ++i) {
        const int k = k0 + wr * 64 + i * 16 + fr;
        const int m1 = tok0 + k, m2 = tok0 + N - k;
#pragma unroll
        for (int j = 0; j < 4; ++j) {
            const int jc = nt * 128 + wc * 64 + j * 16 + fq * 4;
            const float4 bb = *(const float4*)(p.b_four + l * 256 + jc);
            const f32x4 vp = accP[i][j], vq = accQ[i][j];
            {
                const uint2 g = *(const uint2*)(p.px + (size_t)m1 * PXW + PX_GF + jc);
                const float o0 = ((vp[0] + vq[0]) * scale + bb.x) * lo_bf(g.x), o1 = ((vp[1] + vq[1]) * scale + bb.y) * hi_bf(g.x);
                const float o2 = ((vp[2] + vq[2]) * scale + bb.z) * lo_bf(g.y), o3 = ((vp[3] + vq[3]) * scale + bb.w) * hi_bf(g.y);
                *(uint2*)(p.ycat + (size_t)m1 * LDK + 768 + jc) = make_uint2(cvtpk(o0, o1), cvtpk(o2, o3));
            }
            if (k != 0) {
                const uint2 g = *(const uint2*)(p.px + (size_t)m2 * PXW + PX_GF + jc);
                const float o0 = ((vp[0] - vq[0]) * scale + bb.x) * lo_bf(g.x), o1 = ((vp[1] - vq[1]) * scale + bb.y) * hi_bf(g.x);
                const float o2 = ((vp[2] - vq[2]) * scale + bb.z) * lo_bf(g.y), o3 = ((vp[3] - vq[3]) * scale + bb.w) * hi_bf(g.y);
                *(uint2*)(p.ycat + (size_t)m2 * LDK + 768 + jc) = make_uint2(cvtpk(o0, o1), cvtpk(o2, o3));
            }
        }
    }
}
__device__ void nyq_item(const Params& p, int l, int it) {
    const int tid = opaque_tid(), lane = tid & 63, w = tid >> 6;
    const bool lat = it < 256;
    const int q = lat ? it : it - 256, b = q >> 5, j0 = (q & 31) * 8 + w * 2;
    const int N = lat ? 2048 : 256, tok = lat ? (b * 2048 + 1024) : (NTOK + b * 256 + 128);
    const bf16_t* fb = lat ? (p.fbl + (size_t)(b * 256) * LDF) : (p.fbc + (size_t)(b * 256) * 512);
    const int fld = lat ? LDF : 512;
    const float scale = lat ? 0.022097086912079608f : 0.0625f;
    u32x4 v[2][4];
#pragma unroll
    for (int jj = 0; jj < 2; ++jj)
#pragma unroll
        for (int c = 0; c < 4; ++c) {
            const int ch = lane + 64 * c;
            v[jj][c] = (ch < (N >> 3)) ? *(const u32x4*)(fb + (size_t)(j0 + jj) * fld + ch * 8) : (u32x4){0u, 0u, 0u, 0u};
        }
    float gpre[2], bpre[2];
#pragma unroll
    for (int jj = 0; jj < 2; ++jj) { gpre[jj] = bf2f(p.px[(size_t)tok * PXW + PX_GF + j0 + jj]); bpre[jj] = p.b_four[l * 256 + j0 + jj]; }
#pragma unroll
    for (int jj = 0; jj < 2; ++jj) {
        float s = 0.f;
#pragma unroll
        for (int c = 0; c < 4; ++c)
#pragma unroll
            for (int e = 0; e < 4; ++e) s += lo_bf(v[jj][c][e]) - hi_bf(v[jj][c][e]);
#pragma unroll
        for (int o = 32; o >= 1; o >>= 1) s += __shfl_xor(s, o);
        if (lane == 0) {
            const int j = j0 + jj;
            const float o = (s * scale + bpre[jj]) * gpre[jj];
            p.ycat[(size_t)tok * LDK + 768 + j] = (bf16_t)(cvtpk(o, 0.f) & 0xffffu);
        }
    }
}

__device__ void sw_item(const Params& p, int it) {
    const int tid = opaque_tid(), lane = tid & 63, w = tid >> 6;
    const int n0 = it * 16 + w * 4;
    float wv[4][16];
#pragma unroll
    for (int c = 0; c < 4; ++c) {
        const bf16_t* wr_ = p.winT + (size_t)NINP * LDK + (size_t)(n0 + c) * LDK + lane * 16;
        const u32x4 u0 = *(const u32x4*)(wr_), u1 = *(const u32x4*)(wr_ + 8);
#pragma unroll
        for (int e = 0; e < 4; ++e) { wv[c][2 * e] = lo_bf(u0[e]); wv[c][2 * e + 1] = hi_bf(u0[e]); wv[c][8 + 2 * e] = lo_bf(u1[e]); wv[c][8 + 2 * e + 1] = hi_bf(u1[e]); }
    }
#pragma unroll 3
    for (int b = 0; b < 9; ++b) {
        const float* sh = p.mod + ((size_t)9 + b) * 3072 + lane * 16;
        float hv[16];
#pragma unroll
        for (int q = 0; q < 4; ++q) { const float4 t = *(const float4*)(sh + 4 * q); hv[4 * q] = t.x; hv[4 * q + 1] = t.y; hv[4 * q + 2] = t.z; hv[4 * q + 3] = t.w; }
        float acc[4];
#pragma unroll
        for (int c = 0; c < 4; ++c) {
            float a = 0.f;
#pragma unroll
            for (int e = 0; e < 16; ++e) a += hv[e] * wv[c][e];
#pragma unroll
            for (int o = 32; o >= 1; o >>= 1) a += __shfl_xor(a, o);
            acc[c] = a;
        }
        if (lane == 0) *(float4*)(p.sw + (size_t)b * NINP + n0) = make_float4(acc[0], acc[1], acc[2], acc[3]);
    }
}

__device__ void outproj_tile(const Params& p, int l, int mt, int nt, unsigned char* lds) {
    const int tid = opaque_tid(), lane = tid & 63, w = tid >> 6, wr = w >> 1, wc = w & 1, fr = lane & 15, fq = lane >> 4;
    f32x4 acc[4][4];
    gemm_core<true>(p.ycat + (size_t)(mt * 128) * LDK, LDK, p.woutT + (size_t)l * 1024 * LDK + (size_t)(nt * 128) * LDK, LDK, 1024, lds, acc);
    const int chunk = tid & 31, rsub = tid >> 5;
    const int n = nt * 128 + chunk * 4;
    const int m0 = mt * 128;
    const int b = (m0 < NTOK) ? (m0 >> 11) : 8;
    const float* xo; float* xn;
    if (m0 < NTOK) { xo = (l == 0 ? p.x : (const float*)p.out) + (size_t)m0 * DM + n; xn = p.out + (size_t)m0 * DM + n; }
    else { xo = p.ctx + (size_t)(m0 - NTOK) * DM + n; xn = p.x1c + (size_t)(m0 - NTOK) * DM + n; }
    const float4 g = *(const float4*)(p.mod + ((size_t)l * 9 + b) * 3072 + 2048 + n);
    float4 xv[16];
#pragma unroll
    for (int it = 0; it < 16; ++it) xv[it] = *(const float4*)(xo + (size_t)(it * 8 + rsub) * DM);
    float4 gs = make_float4(0.f, 0.f, 0.f, 0.f);
    if (l == 0) {
        const float4 g1 = *(const float4*)(p.norm_g + DM + n), s1 = *(const float4*)(p.mod + ((size_t)9 + b) * 3072 + 1024 + n);
        gs = make_float4(g1.x * (1.f + s1.x), g1.y * (1.f + s1.y), g1.z * (1.f + s1.z), g1.w * (1.f + s1.w));
    }
    float* sC = (float*)lds;
    __syncthreads();
#pragma unroll
    for (int i = 0; i < 4; ++i) {
        const int row = wr * 64 + i * 16 + fr;
#pragma unroll
        for (int j = 0; j < 4; ++j) {
            const int c = wc * 16 + j * 4 + fq;
            *(f32x4*)(sC + row * 128 + ((c ^ (row & 7)) << 2)) = acc[i][j];
        }
    }
    __syncthreads();
    if (l == 1) {
#pragma unroll
        for (int it = 0; it < 16; ++it) {
            const int row = it * 8 + rsub;
            const f32x4 v = *(const f32x4*)(sC + row * 128 + ((chunk ^ (row & 7)) << 2));
            const float4 o = make_float4(xv[it].x + g.x * v[0], xv[it].y + g.y * v[1], xv[it].z + g.z * v[2], xv[it].w + g.w * v[3]);
            xv[it] = o;
            float ss = o.x * o.x + o.y * o.y + o.z * o.z + o.w * o.w;
#pragma unroll
            for (int sh = 16; sh >= 1; sh >>= 1) ss += __shfl_xor(ss, sh);
            if (chunk == 0) atomicAdd(p.rowss2 + m0 + row, ss);
        }
        asm volatile("s_waitcnt vmcnt(0)" ::: "memory");
        __syncthreads();
        if (tid == 0) {
            unsigned* cnt = p.pcnt + mt * 16;
            __builtin_amdgcn_fence(__ATOMIC_RELEASE, "agent");
            asm volatile("s_waitcnt vmcnt(0)" ::: "memory");
            (void)__hip_atomic_fetch_add(cnt, 1u, __ATOMIC_RELAXED, __HIP_MEMORY_SCOPE_AGENT);
            unsigned sp = 0;
            while (__hip_atomic_load(cnt, __ATOMIC_RELAXED, __HIP_MEMORY_SCOPE_AGENT) < 8u) { __builtin_amdgcn_s_sleep(1); if (++sp > (1u << 22)) break; }
            __builtin_amdgcn_fence(__ATOMIC_ACQUIRE, "agent");
            asm volatile("s_waitcnt vmcnt(0)" ::: "memory");
        }
        __syncthreads();
        const float4 fg = *(const float4*)(p.final_g + n);
#pragma unroll
        for (int it = 0; it < 16; ++it) {
            const int row = it * 8 + rsub;
            const float ssum = __hip_atomic_load(p.rowss2 + m0 + row, __ATOMIC_RELAXED, __HIP_MEMORY_SCOPE_AGENT);
            const float rstd = rsqrtf(ssum * (1.f / 1024.f) + 1e-6f);
            *(float4*)(xn + (size_t)row * DM) = make_float4(xv[it].x * rstd * fg.x, xv[it].y * rstd * fg.y, xv[it].z * rstd * fg.z, xv[it].w * rstd * fg.w);
        }
        return;
    }
#pragma unroll
    for (int it = 0; it < 16; ++it) {
        const int row = it * 8 + rsub;
        const f32x4 v = *(const f32x4*)(sC + row * 128 + ((chunk ^ (row & 7)) << 2));
        const float4 o = make_float4(xv[it].x + g.x * v[0], xv[it].y + g.y * v[1], xv[it].z + g.z * v[2], xv[it].w + g.w * v[3]);
        *(float4*)(xn + (size_t)row * DM) = o;
        if (l == 0) {
            *(uint2*)(p.hx + (size_t)(m0 + row) * LDK + n) = make_uint2(cvtpk(o.x * gs.x, o.y * gs.y), cvtpk(o.z * gs.z, o.w * gs.w));
            float ss = o.x * o.x + o.y * o.y + o.z * o.z + o.w * o.w;
#pragma unroll
            for (int sh = 16; sh >= 1; sh >>= 1) ss += __shfl_xor(ss, sh);
            if (chunk == 0) atomicAdd(p.rowss + m0 + row, ss);
        }
    }
}

__device__ void attn_item(const Params& p, int l, int item, unsigned char* lds) {
    const int tid = opaque_tid(), lane = tid & 63, w = tid >> 6, r = lane & 31, hh = lane >> 5;
    int b, n, hp; bool isctx;
    if (item < 512) { b = item >> 6; n = (item >> 2) & 15; hp = item & 3; isctx = false; }
    else { const int q = item - 512; b = q >> 3; n = (q >> 2) & 1; hp = q & 3; isctx = true; }
    const int kvh = hp >> 1, h0 = hp * 2;
    const int qrow0 = isctx ? (NTOK + b * 256 + n * 128) : (b * 2048 + n * 128);
    int lo = 0, hi = 0;
    if (!isctx) { lo = (n - 1) * 128; if (lo < 0) lo = 0; hi = (n + 2) * 128; if (hi > 2048) hi = 2048; }
    const int ntiles = 4 + ((hi - lo) >> 6);
    const int qtok = qrow0 + w * 32 + r;
    const int qpos = n * 128 + w * 32 + r;
    bf16x8 qf[2][4];
#pragma unroll
    for (int hq = 0; hq < 2; ++hq) {
        const bf16_t* qp = p.px + (size_t)qtok * PXW + PX_Q + (h0 + hq) * 64 + 8 * hh;
#pragma unroll
        for (int s = 0; s < 4; ++s) qf[hq][s] = *(const bf16x8*)(qp + 16 * s);
    }
    const int lrow = tid >> 3, lchunk = (tid & 7) ^ ((lrow >> 1) & 7);
    unsigned char* la = lds + __builtin_amdgcn_readfirstlane(tid >> 6) * 1024;
    auto issue = [&](int ti) {
        const bf16_t *kb, *vb; int vld;
        if (ti < 4) { kb = p.px + (size_t)(NTOK + b * 256 + ti * 64) * PXW + PX_K + kvh * 64; vb = p.vtc + (size_t)(b * 128 + kvh * 64) * 256 + ti * 64; vld = 256; }
        else { const int pos0 = lo + (ti - 4) * 64; kb = p.px + (size_t)(b * 2048 + pos0) * PXW + PX_K + kvh * 64; vb = p.vtl + (size_t)(b * 128 + kvh * 64) * LDV + pos0; vld = LDV; }
        unsigned char* dst = la + (ti & 3) * 16384;
#pragma unroll
        for (int q = 0; q < 2; ++q) {
            __builtin_amdgcn_global_load_lds((const unsigned*)(kb + (size_t)(lrow + 32 * q) * PXW + lchunk * 8), (unsigned*)(dst + q * 4096), 16, 0, 0);
            __builtin_amdgcn_global_load_lds((const unsigned*)(vb + (size_t)(lrow + 32 * q) * vld + lchunk * 8), (unsigned*)(dst + 8192 + q * 4096), 16, 0, 0);
        }
    };
    const int fsw = (r >> 1) & 7;
    float sinkv[2], mrun[2], lsum[2];
    f32x16 O[2][2];
#pragma unroll
    for (int hq = 0; hq < 2; ++hq) {
        sinkv[hq] = p.attn_sink[l * 8 + h0 + hq] * 1.4426950408889634f; mrun[hq] = sinkv[hq]; lsum[hq] = 0.f;
#pragma unroll
        for (int e = 0; e < 16; ++e) { O[hq][0][e] = 0.f; O[hq][1][e] = 0.f; }
    }
    asm volatile("" :: "v"(qf[0][0]), "v"(qf[0][1]), "v"(qf[0][2]), "v"(qf[0][3]), "v"(qf[1][0]), "v"(qf[1][1]), "v"(qf[1][2]), "v"(qf[1][3]));
    __syncthreads();
    issue(0); issue(1); issue(2);
    const int wq0 = n * 128 + w * 32;
    for (int ti = 0; ti < ntiles; ++ti) {
        const int rem = ntiles - 1 - ti;
        if (rem >= 2) asm volatile("s_waitcnt vmcnt(8)" ::: "memory");
        else if (rem == 1) asm volatile("s_waitcnt vmcnt(4)" ::: "memory");
        else asm volatile("s_waitcnt vmcnt(0)" ::: "memory");
        __builtin_amdgcn_s_barrier();
        asm volatile("" ::: "memory");
        if (ti + 3 < ntiles) issue(ti + 3);
        const bool local = ti >= 4;
        const int pos0 = lo + (ti - 4) * 64;
        const unsigned char* kbuf = lds + (ti & 3) * 16384;
        const unsigned char* vbuf = kbuf + 8192;
#pragma unroll
        for (int kb = 0; kb < 2; ++kb) {
            const int k0 = pos0 + kb * 32;
            const int dlo = wq0 - k0 - 31, dhi = wq0 + 31 - k0;
            if (local && (dhi < -128 || dlo > 128)) continue;
            const bool partial = local && (dlo < -128 || dhi > 128);
            bf16x8 ka[4];
#pragma unroll
            for (int s = 0; s < 4; ++s) ka[s] = *(const bf16x8*)(kbuf + (kb * 32 + r) * 128 + (((2 * s + hh) ^ fsw) << 4));
            bf16x8 pf[2][2];
            f32x16 SS[2];
#pragma unroll
            for (int hq = 0; hq < 2; ++hq) {
#pragma unroll
                for (int e = 0; e < 16; ++e) SS[hq][e] = 0.f;
#pragma unroll
                for (int s = 0; s < 4; ++s) SS[hq] = __builtin_amdgcn_mfma_f32_32x32x16_bf16(ka[s], qf[hq][s], SS[hq], 0, 0, 0);
            }
#pragma unroll
            for (int hq = 0; hq < 2; ++hq) {
                f32x16 S = SS[hq];
                if (partial) {
#pragma unroll
                    for (int e = 0; e < 16; ++e) {
                        const int d = qpos - (k0 + (e & 3) + 8 * (e >> 2) + 4 * hh);
                        if (d > 128 || d < -128) S[e] = -1e30f;
                    }
                }
                float mx = __builtin_fmaxf(__builtin_fmaxf(S[0], S[1]), S[2]);
#pragma unroll
                for (int e = 3; e < 15; e += 2) mx = __builtin_fmaxf(__builtin_fmaxf(mx, S[e]), S[e + 1]);
                mx = __builtin_fmaxf(mx, S[15]);
                if (__any(mx > mrun[hq] + 8.f)) {
                    mx = fmaxf(mx, __shfl_xor(mx, 32));
                    const float mnew = fmaxf(mrun[hq], mx);
                    const float alpha = __builtin_amdgcn_exp2f(mrun[hq] - mnew);
                    mrun[hq] = mnew;
                    lsum[hq] *= alpha;
#pragma unroll
                    for (int e = 0; e < 16; ++e) { O[hq][0][e] *= alpha; O[hq][1][e] *= alpha; }
                }
                float ps0 = 0.f, ps1 = 0.f;
#pragma unroll
                for (int e = 0; e < 16; e += 2) {
                    const float p0 = __builtin_amdgcn_exp2f(S[e] - mrun[hq]), p1 = __builtin_amdgcn_exp2f(S[e + 1] - mrun[hq]);
                    S[e] = p0; S[e + 1] = p1; ps0 += p0; ps1 += p1;
                }
                lsum[hq] += ps0 + ps1;
#pragma unroll
                for (int s2 = 0; s2 < 2; ++s2) {
                    u32x4 pfu;
#pragma unroll
                    for (int e = 0; e < 4; ++e) pfu[e] = cvtpk(S[8 * s2 + 2 * e], S[8 * s2 + 2 * e + 1]);
                    pf[hq][s2] = __builtin_bit_cast(bf16x8, pfu);
                }
            }
#pragma unroll
            for (int s2 = 0; s2 < 2; ++s2)
#pragma unroll
                for (int db = 0; db < 2; ++db) {
                    const unsigned char* vrow = vbuf + (db * 32 + r) * 128 + 8 * hh;
                    const int c0 = 4 * kb + 2 * s2;
                    const bf16x4 v0 = *(const bf16x4*)(vrow + ((c0 ^ fsw) << 4)), v1 = *(const bf16x4*)(vrow + (((c0 + 1) ^ fsw) << 4));
                    const bf16x8 afv = __builtin_shufflevector(v0, v1, 0, 1, 2, 3, 4, 5, 6, 7);
                    O[0][db] = __builtin_amdgcn_mfma_f32_32x32x16_bf16(afv, pf[0][s2], O[0][db], 0, 0, 0);
                    O[1][db] = __builtin_amdgcn_mfma_f32_32x32x16_bf16(afv, pf[1][s2], O[1][db], 0, 0, 0);
                }
        }
    }
#pragma unroll
    for (int hq = 0; hq < 2; ++hq) {
        const int h = h0 + hq;
        float ls = lsum[hq];
        ls += __shfl_xor(ls, 32);
        ls += __builtin_amdgcn_exp2f(sinkv[hq] - mrun[hq]);
        const float inv = 1.f / ls;
#pragma unroll
        for (int db = 0; db < 2; ++db)
#pragma unroll
            for (int g = 0; g < 4; ++g) {
                const int dim = db * 32 + 8 * g + 4 * hh;
                const uint2 ga = *(const uint2*)(p.px + (size_t)qtok * PXW + PX_GA + h * 64 + dim);
                const float o0 = O[hq][db][4 * g + 0] * inv * lo_bf(ga.x), o1 = O[hq][db][4 * g + 1] * inv * hi_bf(ga.x);
                const float o2 = O[hq][db][4 * g + 2] * inv * lo_bf(ga.y), o3 = O[hq][db][4 * g + 3] * inv * hi_bf(ga.y);
                *(uint2*)(p.ycat + (size_t)qtok * LDK + h * 64 + dim) = make_uint2(cvtpk(o0, o1), cvtpk(o2, o3));
            }
    }
}

__device__ void conv_item(const Params& p, int l, int item, float* lds) {
    const int tid = opaque_tid(), lane = tid & 63, w = tid >> 6;
    int row0, len, t0;
    if (item < 512) { const int b = item >> 6; row0 = b * 2048; len = 2048; t0 = (item & 63) * 32; }
    else { const int q = item - 512, b = q >> 3; row0 = NTOK + b * 256; len = 256; t0 = (q & 7) * 32; }
    float wgt[31];
#pragma unroll
    for (int j = 0; j < 31; ++j) wgt[j] = p.conv_w[((size_t)l * 31 + j) * 256 + tid];
    const float cb = p.conv_b[l * 256 + tid];
    u32x4 av[8], gv[8];
#pragma unroll
    for (int q = 0; q < 8; ++q) {
        int id = tid + 256 * q; if (id > 62 * 32 - 1) id = 62 * 32 - 1;
        const int pp = id >> 5, c8 = (id & 31) * 8;
        int pos = t0 - 15 + pp; pos = pos < 0 ? 0 : (pos > len - 1 ? len - 1 : pos);
        const bf16_t* rp = p.px + (size_t)(row0 + pos) * PXW;
        av[q] = *(const u32x4*)(rp + PX_CA + c8); gv[q] = *(const u32x4*)(rp + PX_CB + c8);
    }
    __syncthreads();
#pragma unroll
    for (int q = 0; q < 8; ++q) {
        const int id = tid + 256 * q;
        const int pp = id >> 5, c8 = (id & 31) * 8;
        const int pos = t0 - 15 + pp;
        const float keep = (pos >= 0 && pos < len) ? 1.f : 0.f;
        float u[8];
#pragma unroll
        for (int e = 0; e < 4; ++e) { u[2 * e] = keep * lo_bf(av[q][e]) * sigm_f(lo_bf(gv[q][e])); u[2 * e + 1] = keep * hi_bf(av[q][e]) * sigm_f(hi_bf(gv[q][e])); }
        if (id < 62 * 32) {
            *(float4*)(lds + pp * 256 + c8) = make_float4(u[0], u[1], u[2], u[3]);
            *(float4*)(lds + pp * 256 + c8 + 4) = make_float4(u[4], u[5], u[6], u[7]);
        }
    }
    __syncthreads();
    float win[31];
#pragma unroll
    for (int j = 0; j < 31; ++j) win[j] = lds[j * 256 + tid];
#pragma unroll
    for (int tt = 0; tt < 32; ++tt) {
        float y0 = cb, y1 = 0.f;
#pragma unroll
        for (int j = 0; j < 30; j += 2) { y0 += wgt[j] * win[j]; y1 += wgt[j + 1] * win[j + 1]; }
        y0 += wgt[30] * win[30];
        const float nu = (tt < 31) ? lds[(tt + 31) * 256 + tid] : 0.f;
        lds[tt * 256 + tid] = y0 + y1;
#pragma unroll
        for (int j = 0; j < 30; ++j) win[j] = win[j + 1];
        win[30] = nu;
    }
    __syncthreads();
    const float4 lg = *(const float4*)(p.conv_ln_g + l * 256 + lane * 4), lb = *(const float4*)(p.conv_ln_b + l * 256 + lane * 4);
    uint2 gcv[8];
#pragma unroll
    for (int q = 0; q < 8; ++q) gcv[q] = *(const uint2*)(p.px + (size_t)(row0 + t0 + w * 8 + q) * PXW + PX_GC + lane * 4);
#pragma unroll
    for (int q = 0; q < 8; ++q) {
        const int t = w * 8 + q;
        const float4 v = *(const float4*)(lds + t * 256 + lane * 4);
        float s = v.x + v.y + v.z + v.w;
#pragma unroll
        for (int o = 32; o >= 1; o >>= 1) s += __shfl_xor(s, o);
        const float mu = s * (1.f / 256.f);
        const float d0 = v.x - mu, d1 = v.y - mu, d2 = v.z - mu, d3 = v.w - mu;
        float vs = d0 * d0 + d1 * d1 + d2 * d2 + d3 * d3;
#pragma unroll
        for (int o = 32; o >= 1; o >>= 1) vs += __shfl_xor(vs, o);
        const float rstd = rsqrtf(vs * (1.f / 256.f) + 1e-6f);
        const size_t tok = (size_t)(row0 + t0 + t);
        const uint2 gc = gcv[q];
        const float o0 = silu_f(d0 * rstd * lg.x + lb.x) * lo_bf(gc.x), o1 = silu_f(d1 * rstd * lg.y + lb.y) * hi_bf(gc.x);
        const float o2 = silu_f(d2 * rstd * lg.z + lb.z) * lo_bf(gc.y), o3 = silu_f(d3 * rstd * lg.w + lb.w) * hi_bf(gc.y);
        *(uint2*)(p.ycat + tok * LDK + 512 + lane * 4) = make_uint2(cvtpk(o0, o1), cvtpk(o2, o3));
    }
}

__device__ void final_item(const Params& p, int item) {
    const int tid = opaque_tid(), lane = tid & 63, w = tid >> 6;
    const int m0 = item * 8 + w * 2;
    float* row0 = p.out + (size_t)m0 * DM;
    float4 v[2][4];
#pragma unroll
    for (int rr = 0; rr < 2; ++rr)
#pragma unroll
        for (int i = 0; i < 4; ++i) v[rr][i] = *(const float4*)(row0 + rr * DM + i * 256 + lane * 4);
    float4 g[4];
#pragma unroll
    for (int i = 0; i < 4; ++i) g[i] = *(const float4*)(p.final_g + i * 256 + lane * 4);
#pragma unroll
    for (int rr = 0; rr < 2; ++rr) {
        float ss = 0.f;
#pragma unroll
        for (int i = 0; i < 4; ++i) ss += v[rr][i].x * v[rr][i].x + v[rr][i].y * v[rr][i].y + v[rr][i].z * v[rr][i].z + v[rr][i].w * v[rr][i].w;
#pragma unroll
        for (int o = 32; o >= 1; o >>= 1) ss += __shfl_xor(ss, o);
        const float rstd = rsqrtf(ss * (1.f / 1024.f) + 1e-6f);
#pragma unroll
        for (int i = 0; i < 4; ++i)
            *(float4*)(row0 + rr * DM + i * 256 + lane * 4) = make_float4(v[rr][i].x * rstd * g[i].x, v[rr][i].y * rstd * g[i].y, v[rr][i].z * rstd * g[i].z, v[rr][i].w * rstd * g[i].w);
    }
}

constexpr int N_PHASES = 10;
__device__ void mixer_phase(const Params& p, int l, unsigned char* lds) {
    const int G = gridDim.x, bid = blockIdx.x;
    const int NFx = l == 0 ? 18 : 16, NAx = l == 0 ? 72 : 64, NCx = l == 0 ? 72 : 64, NNx = l == 0 ? 64 : 32, NSx = l == 0 ? 22 : 0;
    const int NSM = NCx + NNx + NSx;
    const int x = bid & 7, S = G >> 3;
    for (int s = bid >> 3; s < 64; s += S) {
        const int i = s - NFx, R = 64 - NFx;
        const int nA = (s < NFx) ? 0 : ((i < NAx) ? (NAx - i + R - 1) / R : 0);
        for (int k = 0;; ++k) {
            int type, idx;
            if (s < NFx) {
                if (k == 0) { type = 0; idx = s < 16 ? x * 16 + s : 128 + x * 2 + (s - 16); }
                else if (k == 1) {
                    const int c = NSM - 1 - s;
                    const int q = c - NCx;
                    if (q < NNx) { type = 3; idx = q < 32 ? x * 32 + q : 256 + x * 32 + (q - 32); }
                    else { type = 4; idx = x * 22 + (q - NNx); }
                }
                else break;
            } else if (k < nA) {
                const int a = i + k * R;
                type = 1; idx = a < 64 ? x * 64 + a : 512 + x * 8 + (a - 64);
            } else {
                const int i0 = NAx - R, ks = k - nA;
                int c;
                if (i < i0) { if (ks > 0) break; c = i; }
                else c = i0 + (i - i0) + ks * (R - i0);
                if (c >= NSM - NFx) break;
                if (c < NCx) { type = 2; idx = c < 64 ? x * 64 + c : 512 + x * 8 + (c - 64); }
                else if (c < NCx + NNx) { const int q = c - NCx; type = 3; idx = q < 32 ? x * 32 + q : 256 + x * 32 + (q - 32); }
                else { type = 4; idx = x * 22 + (c - NCx - NNx); }
            }
            if (type == 0) fourier_tile(p, l, idx, lds);
            else if (type == 1) attn_item(p, l, idx, lds);
            else if (type == 2) conv_item(p, l, idx, (float*)lds);
            else if (type == 3) nyq_item(p, l, idx);
            else sw_item(p, idx);
        }
    }
}
DEV bool gemm_decode(int k, int nMx, int nN, int extra, int& mt, int& nt) {
    const int x = blockIdx.x & 7, S = gridDim.x >> 3, tl = (blockIdx.x >> 3) + k * S, tot = nMx * nN;
    if (tl < tot) { mt = (tl / nN) * 8 + x; nt = tl % nN; return true; }
    const int e = (tl - tot) * 8 + x;
    if (e < extra) { mt = 128 + (e >> 1); nt = (e & 1) ? 17 : 4; return true; }
    return false;
}
__device__ void run_phase(const Params& p, int ph, unsigned char* lds, int dup) {
    const int G = gridDim.x, bid = blockIdx.x;
    switch (ph) {
    case 0: phase0(p, lds); break;
    case 1:
        {
            float* tab = (float*)(lds + 57344);
            for (int i = threadIdx.x; i < 2048; i += 256) tab[i] = cospif((float)i * (1.f / 1024.f));
            __syncthreads();
        }
        {
            int kp = 0, kh = 0;
            for (int r = 0;; ++r) {
                const int ip = kp * G + bid, ih = kh * G + bid;
                const bool hp = ip < 256 + P1_PREP, hh_ = ih < 2304;
                if (!hp && !hh_) break;
                const bool do_h = hh_ && (!hp || ((r + bid + (bid >> 8)) & 1));
                if (do_h) { hx_item(p, 0, ih); ++kh; }
                else { if (ip < 256) fold_item(p, ip, (float*)lds); else phase1_prep(p, ip - 256, lds); ++kp; }
            }
        }
        break;
    case 2:
        { int mt, nt; for (int k = 0; gemm_decode(k, 18, 22, 0, mt, nt); ++k) inproj_tile(p, 0, mt, nt, lds); }
        break;
    case 3: mixer_phase(p, 0, lds); break;
    case 4:
        { int mt, nt; for (int k = 0; gemm_decode(k, 18, 8, 0, mt, nt); ++k) outproj_tile(p, 0, mt, nt, lds); }
        break;
    case 5:
        for (int it = bid; it < 2304; it += G) hx_item(p, 1, it);
        break;
    case 6:
        { int mt, nt; for (int k = 0; gemm_decode(k, 16, 22, 32, mt, nt); ++k) inproj_tile(p, 1, mt, nt, lds); }
        break;
    case 7: mixer_phase(p, 1, lds); break;
    case 8:
        { int mt, nt; for (int k = 0; gemm_decode(k, 16, 8, 0, mt, nt); ++k) outproj_tile(p, 1, mt, nt, lds); }
        break;
    case 9:
        for (int it = bid; it < 2048; it += G) final_item(p, it);
        break;
    }
}

__global__ void __launch_bounds__(256, 2) mega(Params p, int ph_lo, int ph_hi, int ph_dup) {
    __shared__ __attribute__((aligned(16))) unsigned char lds[LDS_BYTES];
#if MK_MULTI
    run_phase(p, ph_lo, lds);
#else
    XcdBarrier xb = xcd_barrier_post(p.bar);
    for (int ph = ph_lo; ph < ph_hi; ++ph) {
        if (ph == 5 || ph == 9) continue;
        const int reps = 1 + ((ph_dup >> ph) & 1);
        for (int r = 0; r < reps; ++r) {
            run_phase(p, ph, lds, ph_dup);
            if (r + 1 < reps) xcd_barrier(xb);
        }
        if (ph + 1 < ph_hi) {
            if (ph_lo < 0) cg::this_grid().sync();
            xcd_barrier(xb);
        }
    }
#endif
}

extern "C" void kernel_launch(void* const* d_in, const int* in_sizes, int n_in, void* d_out, int out_size, void* d_ws, size_t ws_size, hipStream_t stream) {
    Params p{};
    p.x = (const float*)d_in[0]; p.c = (const float*)d_in[1]; p.ctx = (const float*)d_in[2]; p.c_ctx = (const float*)d_in[3];
    p.w_ada = (const float*)d_in[4]; p.b_ada = (const float*)d_in[5]; p.norm_g = (const float*)d_in[6]; p.w_in = (const float*)d_in[7];
    p.attn_sink = (const float*)d_in[8]; p.conv_w = (const float*)d_in[9]; p.conv_b = (const float*)d_in[10]; p.conv_ln_g = (const float*)d_in[11];
    p.conv_ln_b = (const float*)d_in[12]; p.w_four = (const float*)d_in[13]; p.b_four = (const float*)d_in[14]; p.w_out = (const float*)d_in[15];
    p.final_g = (const float*)d_in[16];
    p.out = (float*)d_out;
    unsigned char* ws = (unsigned char*)d_ws;
    size_t off = 0;
    auto take = [&](size_t bytes) { unsigned char* r = ws + off; off += (bytes + 255) & ~(size_t)255; return r; };
    p.bar = (unsigned*)take(XCD_BAR_WORDS * 4);
    p.mod = (float*)take(2 * 9 * 3072 * 4);
    p.rowss = (float*)take((size_t)MTOT * 4);
    p.rowss2 = (float*)take((size_t)NTOK * 4);
    p.pcnt = (unsigned*)take((size_t)128 * 16 * 4);
    p.rope = (float*)take(96 * 16 * 2 * 4);
    p.wc = (float*)take(2 * 2 * 256 * 256 * 4);
    p.winT = (bf16_t*)take((size_t)2 * NINP * LDK * 2);
    p.woutT = (bf16_t*)take((size_t)2 * 1024 * LDK * 2);
    p.dft = (bf16_t*)take((size_t)2048 * LDF * 2);
    p.dftc = (bf16_t*)take((size_t)256 * 512 * 2);
    p.hx = (bf16_t*)take((size_t)MTOT * LDK * 2);
    p.px = (bf16_t*)take((size_t)MTOT * PXW * 2);
    p.vtl = (bf16_t*)take((size_t)8 * 128 * LDV * 2);
    p.vtc = (bf16_t*)take((size_t)8 * 128 * 256 * 2);
    p.fbl = (bf16_t*)take((size_t)8 * 256 * LDF * 2);
    p.fbc = (bf16_t*)take((size_t)8 * 256 * 512 * 2);
    p.ycat = (bf16_t*)take((size_t)MTOT * LDK * 2);
    p.x1c = (float*)take((size_t)NCTXT * 1024 * 4);
    p.fscr = (float*)take((size_t)512 * 16384 * 4);
    p.sw = (float*)take((size_t)9 * NINP * 4);
    if (off > ws_size) { fprintf(stderr, "workspace too small: need %zu have %zu\n", off, ws_size); return; }
#if MK_MULTI
    for (int ph = 0; ph < N_PHASES; ++ph) mega<<<dim3(1024), dim3(256), 0, stream>>>(p, ph, ph + 1);
#else
    static int grid_blocks = 0;
    if (!grid_blocks) {
        int dev = 0, cus = 0, per_cu = 0;
        hipGetDevice(&dev);
        hipDeviceGetAttribute(&cus, hipDeviceAttributeMultiprocessorCount, dev);
        hipOccupancyMaxActiveBlocksPerMultiprocessor(&per_cu, mega, 256, 0);
        if (per_cu > 2) per_cu = 2;
        grid_blocks = (cus * per_cu) & ~7;
        if (grid_blocks > 512) grid_blocks = 512;
        if (grid_blocks < 8) grid_blocks = 8;
    }
    (void)hipMemsetAsync(p.bar, 0, (size_t)((unsigned char*)p.pcnt - (unsigned char*)p.bar) + (size_t)128 * 16 * 4, stream);
#ifndef PH_DUP
#define PH_DUP 0
#endif
    int lo = 0, hi = 9, dup = PH_DUP;
    void* args[] = {&p, &lo, &hi, &dup};
    hipError_t e = hipLaunchCooperativeKernel((void*)mega, dim3(grid_blocks), dim3(256), args, 0, stream);
    if (e != hipSuccess) fprintf(stderr, "cooperative launch failed: %s (grid %d)\n", hipGetErrorString(e), grid_blocks);
#endif
}
```

```cpp
#include <hip/hip_runtime.h>
#include <hip/hip_cooperative_groups.h>
#include <cstdio>
#include <cstdint>
namespace cg = cooperative_groups;

#ifndef MK_MULTI
#define MK_MULTI 0
#endif

typedef unsigned short bf16_t;
typedef short bf16x8 __attribute__((ext_vector_type(8)));
typedef short bf16x4 __attribute__((ext_vector_type(4)));
typedef float f32x4 __attribute__((ext_vector_type(4)));
typedef float f32x16 __attribute__((ext_vector_type(16)));
typedef unsigned u32x4 __attribute__((ext_vector_type(4)));
typedef unsigned u32x2 __attribute__((ext_vector_type(2)));
#define DEV __device__ __forceinline__

constexpr int NTOK = 16384, NCTXT = 2048, MTOT = 18432, DM = 1024;
constexpr int LDK = 1088, LDF = 4160, LDV = 2112;
constexpr int PXW = 2176;
constexpr int PX_Q = 0, PX_K = 512, PX_GA = 640, PX_CA = 1152, PX_CB = 1408, PX_GC = 1664, PX_GF = 1920;
constexpr int NINP = 2816;
constexpr int LDS_BYTES = 65536;

struct Params {
    const float *x, *c, *ctx, *c_ctx, *w_ada, *b_ada, *norm_g, *w_in, *attn_sink, *conv_w, *conv_b, *conv_ln_g, *conv_ln_b,
        *w_four, *b_four, *w_out, *final_g;
    float* out;
    unsigned* bar;
    float* mod;
    float* rope;
    float* wc;
    bf16_t* winT;
    bf16_t* woutT;
    bf16_t* dft;
    bf16_t* dftc;
    bf16_t* hx;
    bf16_t* px;
    bf16_t* vtl;
    bf16_t* vtc;
    bf16_t* fbl;
    bf16_t* fbc;
    bf16_t* ycat;
    float* x1c;
    float* fscr;
    float* rowss;
    float* rowss2;
    unsigned* pcnt;
    float* sw;
};

DEV float bf2f(bf16_t v) { return __uint_as_float(((unsigned)v) << 16); }
typedef __bf16 bf16v2 __attribute__((ext_vector_type(2)));
typedef float f32v2 __attribute__((ext_vector_type(2)));
DEV unsigned cvtpk(float lo, float hi) { f32v2 v = {lo, hi}; bf16v2 b = __builtin_convertvector(v, bf16v2); return __builtin_bit_cast(unsigned, b); }
DEV float silu_f(float v) { return v * __builtin_amdgcn_rcpf(1.f + __expf(-v)); }
DEV float sigm_f(float v) { return __builtin_amdgcn_rcpf(1.f + __expf(-v)); }
DEV int opaque_tid() { int t = threadIdx.x; asm volatile("" : "+v"(t)); return t; }
DEV float lo_bf(unsigned u) { return __uint_as_float(u << 16); }
DEV float hi_bf(unsigned u) { return __uint_as_float(u & 0xffff0000u); }

#define XB_TMO      128
#define XB_XCNT(j)  (256  + 64 * (j))
#define XB_XSUB(j)  (1280 + 64 * (j))
#define XB_XGEN(j)  (2304 + 64 * (j))
#define XB_TOP      3328
#define XB_TOPGEN   3392
#define XCD_BAR_WORDS 3456
#define XB_SPIN_CAP (1u << 22)
#define LAS __attribute__((address_space(3)))
DEV unsigned xb_ld(unsigned* p) { return __hip_atomic_load(p, __ATOMIC_RELAXED, __HIP_MEMORY_SCOPE_AGENT); }
DEV unsigned xb_add(unsigned* p, unsigned v) { return __hip_atomic_fetch_add(p, v, __ATOMIC_RELAXED, __HIP_MEMORY_SCOPE_AGENT); }
DEV unsigned xb_xcc_id() { return (unsigned)__builtin_amdgcn_s_getreg((3 << 11) | 20) & 0xFu; }
#define XB_SPIN(cond, bar) do { unsigned _sp = 0; while (cond) { __builtin_amdgcn_s_sleep(1); \
    if ((++_sp & 255u) == 0u) { if (xb_ld(&(bar)[XB_TMO])) break; if (_sp > XB_SPIN_CAP) { atomicAdd(&(bar)[XB_TMO], 1u); break; } } } } while (0)
struct XcdBarrier { unsigned* bar; unsigned x; unsigned nloc, nx; };
DEV XcdBarrier xcd_barrier_post(unsigned* bar) {
    XcdBarrier b; b.bar = bar; b.x = xb_xcc_id(); b.nloc = 0u; b.nx = 0u;
    if (threadIdx.x == 0) (void)xb_add(&bar[XB_XCNT(b.x)], 1u);
    return b;
}
DEV void xcd_barrier_complete(unsigned* bar, unsigned x, unsigned& nloc, unsigned& nx) {
    const unsigned G = gridDim.x * gridDim.y * gridDim.z;
    unsigned sum, cnt, mine, sp = 0u;
    for (;;) {
        sum = 0u; cnt = 0u; mine = 0u;
#pragma unroll
        for (unsigned j = 0; j < 16; ++j) { const unsigned c = xb_ld(&bar[XB_XCNT(j)]); sum += c; cnt += (c > 0u) ? 1u : 0u; mine = (j == x) ? c : mine; }
        if (sum == G) break;
        __builtin_amdgcn_s_sleep(1);
        if ((++sp & 255u) == 0u) { if (xb_ld(&bar[XB_TMO])) break; if (sp > XB_SPIN_CAP) { atomicAdd(&bar[XB_TMO], 1u); break; } }
    }
    nloc = mine > 0u ? mine : 1u; nx = cnt > 0u ? cnt : 1u;
}
DEV void xcd_barrier(XcdBarrier& b) {
    asm volatile("s_waitcnt vmcnt(0)" ::: "memory");
    __syncthreads();
    if (threadIdx.x == 0) {
        unsigned* bar = b.bar;
        __builtin_amdgcn_s_waitcnt(0);
        unsigned nloc = b.nloc, nx = b.nx;
        if (nloc == 0u) { xcd_barrier_complete(bar, b.x, nloc, nx); b.nloc = nloc; b.nx = nx; }
        const unsigned old = xb_add(&bar[XB_XSUB(b.x)], 1u);
        const unsigned gen = old / nloc;
        if (old + 1u == (gen + 1u) * nloc) {
            __builtin_amdgcn_fence(__ATOMIC_RELEASE, "agent");
            asm volatile("s_waitcnt vmcnt(0)" ::: "memory");
            const unsigned og = xb_add(&bar[XB_TOP], 1u);
            const unsigned tg = og / nx;
            if (og + 1u == (tg + 1u) * nx) xb_add(&bar[XB_TOPGEN], 1u);
            else XB_SPIN(xb_ld(&bar[XB_TOPGEN]) == tg, bar);
            __builtin_amdgcn_fence(__ATOMIC_ACQUIRE, "agent");
            xb_add(&bar[XB_XGEN(b.x)], 1u);
            asm volatile("s_waitcnt vmcnt(0)" ::: "memory");
        } else {
            XB_SPIN(xb_ld(&bar[XB_XGEN(b.x)]) == gen, bar);
            __builtin_amdgcn_fence(__ATOMIC_ACQUIRE, "agent");
            asm volatile("s_waitcnt vmcnt(0)" ::: "memory");
        }
    }
    __syncthreads();
}

__device__ void ada_item(const Params& p, int item, float* lds) {
    const int tid = opaque_tid();
    const int l = item / 192, r = item % 192, kc = r / 12, jc = r % 12;
    const int k0 = kc * 64, j = jc * 256 + tid;
    __syncthreads();
#pragma unroll
    for (int q = 0; q < 3; ++q) {
        const int idx = tid + 256 * q;
        if (idx < 576) {
            const int b = idx >> 6, kk = idx & 63;
            const float v = (b < 8) ? p.c[b * 1024 + k0 + kk] : p.c_ctx[k0 + kk];
            lds[idx] = v * __builtin_amdgcn_rcpf(1.f + __expf(-v));
        }
    }
    __syncthreads();
    float acc[9];
#pragma unroll
    for (int b = 0; b < 9; ++b) acc[b] = 0.f;
    const float* wp = p.w_ada + (size_t)l * 1024 * 3072 + (size_t)k0 * 3072 + j;
#pragma unroll 32
    for (int kk = 0; kk < 64; ++kk) {
        const float wv = wp[(size_t)kk * 3072];
#pragma unroll
        for (int b = 0; b < 9; ++b) acc[b] += lds[b * 64 + kk] * wv;
    }
    const float bias = (kc == 0) ? p.b_ada[l * 3072 + j] : 0.f;
#pragma unroll
    for (int b = 0; b < 9; ++b) atomicAdd(p.mod + ((size_t)l * 9 + b) * 3072 + j, acc[b] + bias);
}

__device__ void wc_item(const Params& p, int item, const float* tab) {
    const int tid = opaque_tid(), lane = tid & 63, w = tid >> 6, li = lane & 31, kk = lane >> 5;
    const int jq = item & 1, ct = (item >> 1) & 1, h = (item >> 2) & 3, part = (item >> 4) & 1, l = item >> 5;
    const int cc = ct * 32 + li, j0 = jq * 128 + w * 32;
    const int ph = part ? 1536 : 0;
    const float* wf = p.w_four + (size_t)l * 65536 + (size_t)(h * 64 + kk) * 256 + j0 + li;
    f32x16 acc;
#pragma unroll
    for (int e = 0; e < 16; ++e) acc[e] = 0.f;
#pragma unroll 8
    for (int t = 0; t < 32; ++t) {
        const int m = 2 * t + kk;
        acc = __builtin_amdgcn_mfma_f32_32x32x2f32(tab[(32 * cc * m + ph) & 2047], wf[(2 * t) * 256], acc, 0, 0, 0);
    }
    float* op = p.wc + ((size_t)(l * 2 + part) * 256 + h * 64 + ct * 32 + 4 * kk) * 256 + j0 + li;
#pragma unroll
    for (int e = 0; e < 16; ++e) op[((e & 3) + 8 * (e >> 2)) * 256] = acc[e] * 0.125f;
}

__device__ void transpose_tile(const float* src, int sld, bf16_t* dst, int dld, float* t) {
    const int tid = opaque_tid();
    __syncthreads();
#pragma unroll
    for (int i = 0; i < 4; ++i) {
        const int id = tid + 256 * i, k = id >> 4, c = id & 15;
        const float4 v = *(const float4*)(src + (size_t)k * sld + c * 4);
        t[k * 65 + c * 4 + 0] = v.x; t[k * 65 + c * 4 + 1] = v.y; t[k * 65 + c * 4 + 2] = v.z; t[k * 65 + c * 4 + 3] = v.w;
    }
    __syncthreads();
    const int n = tid >> 2, kq = tid & 3;
    unsigned o[8];
#pragma unroll
    for (int e = 0; e < 8; ++e) o[e] = cvtpk(t[(kq * 16 + 2 * e) * 65 + n], t[(kq * 16 + 2 * e + 1) * 65 + n]);
    uint4* d = (uint4*)(dst + (size_t)n * dld + kq * 16);
    d[0] = make_uint4(o[0], o[1], o[2], o[3]);
    d[1] = make_uint4(o[4], o[5], o[6], o[7]);
}

DEV int win_dst_row(int n) {
    if (n < 640) return n;
    if (n < 768) return 2176 + (n - 640);
    if (n < 1280) return 640 + (n - 768);
    if (n < 1536) return 1152 + (n - 1280);
    if (n < 1792) return 1408 + (n - 1536);
    if (n < 2048) return 1664 + (n - 1792);
    return 1920 + (n - 2304);
}

__device__ void dft_item(const Params& p, int item, const float* tab) {
    const int tid = opaque_tid();
#pragma unroll
    for (int q = 0; q < 4; ++q) {
        const int idx = ((item * 4 + q) * 256 + tid) * 8;
        const int k = idx >> 12, n0 = idx & 4095;
        const int ph = (n0 < 2048) ? 0 : 512;
        unsigned o[4];
#pragma unroll
        for (int e = 0; e < 4; ++e) {
            const int n = (n0 + 2 * e) & 2047;
            o[e] = cvtpk(tab[(k * n + ph) & 2047], tab[(k * (n + 1) + ph) & 2047]);
        }
        *(uint4*)(p.dft + (size_t)k * LDF + n0) = make_uint4(o[0], o[1], o[2], o[3]);
    }
}
__device__ void dftc_item(const Params& p, int item, const float* tab) {
    const int idx = (item * 256 + opaque_tid()) * 8;
    const int k = idx >> 9, n0 = idx & 511;
    const int ph = (n0 < 256) ? 0 : 512;
    unsigned o[4];
#pragma unroll
    for (int e = 0; e < 4; ++e) {
        const int n = (n0 + 2 * e) & 255;
        o[e] = cvtpk(tab[(8 * k * n + ph) & 2047], tab[(8 * k * (n + 1) + ph) & 2047]);
    }
    *(uint4*)(p.dftc + idx) = make_uint4(o[0], o[1], o[2], o[3]);
}
__device__ void rope_item(const Params& p) {
    for (int i = threadIdx.x; i < 96 * 16; i += 256) {
        const int pp = i >> 4, f = i & 15;
        const float pos = (float)(pp < 32 ? pp : pp - 32);
        const float freq = powf(10000.f, -(float)f / 16.f);
        const float ang = pos * freq;
        p.rope[i * 2] = cosf(ang); p.rope[i * 2 + 1] = sinf(ang);
    }
}

__device__ void phase0(const Params& p, unsigned char* lds) {
    constexpr int N_ADA = 384, N_WC = 64;
    float* tab = (float*)(lds + 57344);
    for (int i = threadIdx.x; i < 2048; i += 256) tab[i] = cospif((float)i * (1.f / 1024.f));
    __syncthreads();
    for (int it = blockIdx.x; it < N_ADA + N_WC; it += gridDim.x) {
        if (it < N_WC) wc_item(p, it, tab);
        else ada_item(p, it - N_WC, (float*)lds);
    }
}
__device__ void phase1_prep(const Params& p, int it, unsigned char* lds) {
    constexpr int O3 = 1152, O4 = O3 + 512, O5 = O4 + 1024, O6 = O5 + 64;
    const float* tab = (const float*)(lds + 57344);
    if (it < O3) {
        const int q = it, l = q / 576, r = q % 576, ct = r >> 4, kt = r & 15;
        const int n0 = ct < 32 ? ct * 64 : 2304 + (ct - 32) * 64;
        transpose_tile(p.w_in + (size_t)l * 1024 * 2560 + (size_t)(kt * 64) * 2560 + n0, 2560,
                       p.winT + (size_t)l * NINP * LDK + (size_t)win_dst_row(n0) * LDK + kt * 64, LDK, (float*)lds);
    } else if (it < O4) {
        const int q = it - O3, l = q >> 8, r = q & 255, ct = r >> 4, kt = r & 15;
        transpose_tile(p.w_out + (size_t)l * 1048576 + (size_t)(kt * 64) * 1024 + ct * 64, 1024,
                       p.woutT + (size_t)l * 1024 * LDK + (size_t)(ct * 64) * LDK + kt * 64, LDK, (float*)lds);
    } else if (it < O5) dft_item(p, it - O4, tab);
    else if (it < O6) dftc_item(p, it - O5, tab);
    else rope_item(p);
}
constexpr int P1_PREP = 1152 + 512 + 1024 + 64 + 1;

__device__ void fold_item(const Params& p, int item, float* lds) {
    const int tid = opaque_tid(), lane = tid & 63, w = tid >> 6, wr = w >> 1, wc = w & 1, li = lane & 31, kk = lane >> 5;
    const int l = item >> 7, part = (item >> 6) & 1, kt = (item >> 2) & 15, jt = item & 3;
    const int k0 = kt * 64 + wr * 32, j0 = jt * 64 + wc * 32;
    const float* ap = p.w_in + (size_t)l * 1024 * 2560 + (size_t)(k0 + li) * 2560 + 2048 + 4 * kk;
    const float* bp = p.wc + ((size_t)(l * 2 + part) * 256 + 4 * kk) * 256 + j0 + li;
    f32x16 acc;
#pragma unroll
    for (int e = 0; e < 16; ++e) acc[e] = 0.f;
#pragma unroll 4
    for (int u = 0; u < 32; ++u) {
        const float4 a = *(const float4*)(ap + 8 * u);
        const float b0 = bp[(8 * u + 0) * 256], b1 = bp[(8 * u + 1) * 256], b2 = bp[(8 * u + 2) * 256], b3 = bp[(8 * u + 3) * 256];
        acc = __builtin_amdgcn_mfma_f32_32x32x2f32(a.x, b0, acc, 0, 0, 0);
        acc = __builtin_amdgcn_mfma_f32_32x32x2f32(a.y, b1, acc, 0, 0, 0);
        acc = __builtin_amdgcn_mfma_f32_32x32x2f32(a.z, b2, acc, 0, 0, 0);
        acc = __builtin_amdgcn_mfma_f32_32x32x2f32(a.w, b3, acc, 0, 0, 0);
    }
    bf16_t* op = p.winT + (size_t)l * NINP * LDK + (size_t)(2304 + part * 256 + j0 + li) * LDK + k0 + 4 * kk;
#pragma unroll
    for (int g = 0; g < 4; ++g)
        *(uint2*)(op + 8 * g) = make_uint2(cvtpk(acc[4 * g + 0], acc[4 * g + 1]), cvtpk(acc[4 * g + 2], acc[4 * g + 3]));
}

__device__ void hx_item(const Params& p, int l, int item) {
    const int tid = opaque_tid(), lane = tid & 63, w = tid >> 6;
    const int m0 = item * 8 + w * 2;
    const float* src0;
    if (l == 0) src0 = (m0 < NTOK) ? p.x + (size_t)m0 * DM : p.ctx + (size_t)(m0 - NTOK) * DM;
    else src0 = (m0 < NTOK) ? p.out + (size_t)m0 * DM : p.x1c + (size_t)(m0 - NTOK) * DM;
    const int b = (m0 < NTOK) ? (m0 >> 11) : 8;
    float4 v[2][4];
#pragma unroll
    for (int rr = 0; rr < 2; ++rr)
#pragma unroll
        for (int i = 0; i < 4; ++i) v[rr][i] = *(const float4*)(src0 + rr * DM + i * 256 + lane * 4);
    const float* g = p.norm_g + l * DM;
    const float* sh = p.mod + ((size_t)l * 9 + b) * 3072;
    const float* sc = sh + 1024;
    float4 gm[4], hm[4];
#pragma unroll
    for (int i = 0; i < 4; ++i) {
        const int col = i * 256 + lane * 4;
        const float4 gg = *(const float4*)(g + col), s4 = *(const float4*)(sc + col);
        hm[i] = *(const float4*)(sh + col);
        gm[i] = make_float4(gg.x * (1.f + s4.x), gg.y * (1.f + s4.y), gg.z * (1.f + s4.z), gg.w * (1.f + s4.w));
    }
#pragma unroll
    for (int rr = 0; rr < 2; ++rr) {
        float ss = 0.f;
#pragma unroll
        for (int i = 0; i < 4; ++i) ss += v[rr][i].x * v[rr][i].x + v[rr][i].y * v[rr][i].y + v[rr][i].z * v[rr][i].z + v[rr][i].w * v[rr][i].w;
#pragma unroll
        for (int o = 32; o >= 1; o >>= 1) ss += __shfl_xor(ss, o);
        const float rstd = rsqrtf(ss * (1.f / 1024.f) + 1e-6f);
#pragma unroll
        for (int i = 0; i < 4; ++i) {
            const int col = i * 256 + lane * 4;
            const float a0 = v[rr][i].x * rstd * gm[i].x + hm[i].x;
            const float a1 = v[rr][i].y * rstd * gm[i].y + hm[i].y;
            const float a2 = v[rr][i].z * rstd * gm[i].z + hm[i].z;
            const float a3 = v[rr][i].w * rstd * gm[i].w + hm[i].w;
            *(uint2*)(p.hx + (size_t)(m0 + rr) * LDK + col) = make_uint2(cvtpk(a0, a1), cvtpk(a2, a3));
        }
    }
}

template <bool SWAP>
DEV void gemm_core(const bf16_t* __restrict__ A, int lda, const bf16_t* __restrict__ Bt, int ldb, int K, unsigned char* lds, f32x4 (&acc)[4][4]) {
    const int tid = opaque_tid(), lane = tid & 63, w = tid >> 6, wr = w >> 1, wc = w & 1;
    const int fr = lane & 15, fq = lane >> 4;
    const int srow = tid >> 3, sc = (tid & 7) ^ ((srow >> 1) & 7);
    const bf16_t* ga = A + (size_t)srow * lda + sc * 8;
    const bf16_t* gb = Bt + (size_t)srow * ldb + sc * 8;
    unsigned char* la = lds + __builtin_amdgcn_readfirstlane(tid >> 6) * 1024;
#define GEMM_STAGE(buf, kt) do { \
        _Pragma("unroll") for (int _i = 0; _i < 4; ++_i) { \
            __builtin_amdgcn_global_load_lds((const unsigned*)(ga + (size_t)(32 * _i) * lda + (kt) * 64), (unsigned*)(la + (buf) * 32768 + _i * 4096), 16, 0, 0); \
            __builtin_amdgcn_global_load_lds((const unsigned*)(gb + (size_t)(32 * _i) * ldb + (kt) * 64), (unsigned*)(la + (buf) * 32768 + 16384 + _i * 4096), 16, 0, 0); \
        } } while (0)
#pragma unroll
    for (int i = 0; i < 4; ++i)
#pragma unroll
        for (int j = 0; j < 4; ++j) acc[i][j] = (f32x4){0.f, 0.f, 0.f, 0.f};
    const int nk = K >> 6;
    const int po0 = (fq ^ (fr >> 1)) * 16, po1 = ((4 + fq) ^ (fr >> 1)) * 16;
    const unsigned char* fa = lds + (wr * 64 + fr) * 128;
    const unsigned char* fb = lds + 16384 + (wc * 64 + fr) * 128;
    __syncthreads();
    GEMM_STAGE(0, 0);
    for (int kt = 0; kt < nk; ++kt) {
        asm volatile("s_waitcnt vmcnt(0)" ::: "memory");
        __syncthreads();
        const int buf = kt & 1;
        if (kt + 1 < nk) GEMM_STAGE(buf ^ 1, kt + 1);
        bf16x8 af[2][4], bfr[2][4];
#pragma unroll
        for (int ks = 0; ks < 2; ++ks) {
            const int po = ks ? po1 : po0;
            bfr[ks][0] = *(const bf16x8*)(fb + buf * 32768 + 0 * 2048 + po);
            af[ks][0] = *(const bf16x8*)(fa + buf * 32768 + 0 * 2048 + po);
#pragma unroll
            for (int j = 1; j < 4; ++j) bfr[ks][j] = *(const bf16x8*)(fb + buf * 32768 + j * 2048 + po);
#pragma unroll
            for (int i = 1; i < 4; ++i) af[ks][i] = *(const bf16x8*)(fa + buf * 32768 + i * 2048 + po);
        }
#pragma unroll
        for (int ks = 0; ks < 2; ++ks)
#pragma unroll
            for (int i = 0; i < 4; ++i)
#pragma unroll
                for (int j = 0; j < 4; ++j) {
                    if (SWAP) acc[i][j] = __builtin_amdgcn_mfma_f32_16x16x32_bf16(bfr[ks][j], af[ks][i], acc[i][j], 0, 0, 0);
                    else      acc[i][j] = __builtin_amdgcn_mfma_f32_16x16x32_bf16(af[ks][i], bfr[ks][j], acc[i][j], 0, 0, 0);
                }
        __builtin_amdgcn_sched_group_barrier(0x100, 5, 0);
#pragma unroll
        for (int q = 0; q < 11; ++q) { __builtin_amdgcn_sched_group_barrier(0x008, 1, 0); __builtin_amdgcn_sched_group_barrier(0x100, 1, 0); }
        __builtin_amdgcn_sched_group_barrier(0x008, 21, 0);
    }
#undef GEMM_STAGE
}

__device__ void inproj_tile(const Params& p, int l, int mt, int nt, unsigned char* lds) {
    const int tid = opaque_tid(), lane = tid & 63, w = tid >> 6, wr = w >> 1, wc = w & 1, fr = lane & 15, fq = lane >> 4;
    const bf16_t* A = p.hx + (size_t)(mt * 128) * LDK;
    const bf16_t* Bt = p.winT + (size_t)l * NINP * LDK + (size_t)(nt * 128) * LDK;
    f32x4 acc[4][4];
    const bool latent = mt < 128;
    const int bb = latent ? (mt >> 4) : 8;
    if (nt < 17) {
        f32x4 bias[4]; float rss[4];
        if (l == 1) {
#pragma unroll
            for (int j = 0; j < 4; ++j) bias[j] = *(const f32x4*)(p.sw + (size_t)bb * NINP + nt * 128 + wc * 64 + j * 16 + fq * 4);
#pragma unroll
            for (int i = 0; i < 4; ++i) rss[i] = p.rowss[mt * 128 + wr * 64 + i * 16 + fr];
        }
        gemm_core<true>(A, LDK, Bt, LDK, 1024, lds, acc);
        if (l == 1) {
#pragma unroll
            for (int i = 0; i < 4; ++i) {
                const float rstd = rsqrtf(rss[i] * (1.f / 1024.f) + 1e-6f);
#pragma unroll
                for (int j = 0; j < 4; ++j) acc[i][j] = acc[i][j] * rstd + bias[j];
            }
        }
        const bool isq = nt < 4, isk = nt == 4;
        const bool gated = (nt >= 5 && nt <= 8) || (nt >= 13);
#pragma unroll
        for (int i = 0; i < 4; ++i) {
            const int m = mt * 128 + wr * 64 + i * 16 + fr;
            if ((isq || isk) && latent) {
                const int t = m & 2047, rp = t >> 6, cp = 32 + (t & 63);
                const float4* r1 = (const float4*)(p.rope + (rp * 16 + fq * 4) * 2);
                const float4* r2 = (const float4*)(p.rope + (cp * 16 + fq * 4) * 2);
                const float4 ra0 = r1[0], ra1 = r1[1], rb0 = r2[0], rb1 = r2[1];
                const float cr[4] = {ra0.x, ra0.z, ra1.x, ra1.z}, sr[4] = {ra0.y, ra0.w, ra1.y, ra1.w};
                const float cc[4] = {rb0.x, rb0.z, rb1.x, rb1.z}, sc[4] = {rb0.y, rb0.w, rb1.y, rb1.w};
#pragma unroll
                for (int e = 0; e < 4; ++e) {
                    const float x1 = acc[i][0][e], x2 = acc[i][1][e];
                    acc[i][0][e] = x1 * cr[e] - x2 * sr[e]; acc[i][1][e] = x1 * sr[e] + x2 * cr[e];
                    const float y1 = acc[i][2][e], y2 = acc[i][3][e];
                    acc[i][2][e] = y1 * cc[e] - y2 * sc[e]; acc[i][3][e] = y1 * sc[e] + y2 * cc[e];
                }
            }
            bf16_t* orow = p.px + (size_t)m * PXW + nt * 128 + wc * 64 + fq * 4;
#pragma unroll
            for (int j = 0; j < 4; ++j) {
                f32x4 v = acc[i][j];
                if (isq) v = v * 0.18033688011112042f;
                if (gated) { v[0] = silu_f(v[0]); v[1] = silu_f(v[1]); v[2] = silu_f(v[2]); v[3] = silu_f(v[3]); }
                *(uint2*)(orow + j * 16) = make_uint2(cvtpk(v[0], v[1]), cvtpk(v[2], v[3]));
            }
        }
    } else {
        gemm_core<false>(A, LDK, Bt, LDK, 1024, lds, acc);
        if (l == 1) {
            float bias[4];
#pragma unroll
            for (int j = 0; j < 4; ++j) bias[j] = p.sw[(size_t)bb * NINP + nt * 128 + wc * 64 + j * 16 + fr];
#pragma unroll
            for (int i = 0; i < 4; ++i) {
                const float4 ss = *(const float4*)(p.rowss + mt * 128 + wr * 64 + i * 16 + fq * 4);
                const f32x4 rs = {rsqrtf(ss.x * (1.f / 1024.f) + 1e-6f), rsqrtf(ss.y * (1.f / 1024.f) + 1e-6f), rsqrtf(ss.z * (1.f / 1024.f) + 1e-6f), rsqrtf(ss.w * (1.f / 1024.f) + 1e-6f)};
#pragma unroll
                for (int j = 0; j < 4; ++j) acc[i][j] = acc[i][j] * rs + bias[j];
            }
        }
        int b, t0, T;
        if (latent) { b = mt >> 4; t0 = (mt & 15) * 128; T = 2048; }
        else { const int q = mt - 128; b = q >> 1; t0 = (q & 1) * 128; T = 256; }
        bf16_t* base; size_t ld;
        if (nt == 17) { ld = latent ? LDV : 256; base = (latent ? p.vtl : p.vtc) + (size_t)(b * 128) * ld; }
        else {
            const int part = (nt >= 20), jb = ((nt - 18) & 1) * 128;
            ld = latent ? LDF : 512;
            base = (latent ? p.fbl : p.fbc) + ((size_t)(b * 256 + jb)) * ld + part * T;
        }
#pragma unroll
        for (int i = 0; i < 4; ++i) {
            const int t = t0 + wr * 64 + i * 16 + fq * 4;
#pragma unroll
            for (int j = 0; j < 4; ++j) {
                const int n = wc * 64 + j * 16 + fr;
                const f32x4 v = acc[i][j];
                *(uint2*)(base + (size_t)n * ld + t) = make_uint2(cvtpk(v[0], v[1]), cvtpk(v[2], v[3]));
            }
        }
    }
}

__device__ void fourier_tile(const Params& p, int l, int it, unsigned char* lds) {
    const int tid = opaque_tid(), lane = tid & 63, w = tid >> 6, wr = w >> 1, wc = w & 1, fr = lane & 15, fq = lane >> 4;
    const bf16_t *A, *Bt; int ld, N, tok0, k0, nt; float scale;
    if (it < 128) {
        const int b = it >> 4, kt = (it >> 1) & 7; nt = it & 1;
        A = p.dft + (size_t)(kt * 128) * LDF; Bt = p.fbl + (size_t)(b * 256 + nt * 128) * LDF; ld = LDF; N = 2048;
        tok0 = b * 2048; k0 = kt * 128; scale = 0.022097086912079608f;
    } else {
        const int q = it - 128, b = q >> 1; nt = q & 1;
        A = p.dftc; Bt = p.fbc + (size_t)(b * 256 + nt * 128) * 512; ld = 512; N = 256;
        tok0 = NTOK + b * 256; k0 = 0; scale = 0.0625f;
    }
    f32x4 accP[4][4], accQ[4][4];
    f32x4* scr = (f32x4*)(p.fscr + (size_t)blockIdx.x * 16384) + tid;
    gemm_core<true>(A, ld, Bt, ld, N, lds, accQ);
#pragma unroll
    for (int i = 0; i < 4; ++i)
#pragma unroll
        for (int j = 0; j < 4; ++j) scr[(i * 4 + j) * 256] = accQ[i][j];
    gemm_core<true>(A + N, ld, Bt + N, ld, N, lds, accQ);
#pragma unroll
    for (int i = 0; i < 4; ++i)
#pragma unroll
        for (int j = 0; j < 4; ++j) accP[i][j] = scr[(i * 4 + j) * 256];
#pragma unroll
    for (int i = 0; i < 4; ++i) {
        const int k = k0 + wr * 64 + i * 16 + fr;
        const int m1 = tok0 + k, m2 = tok0 + N - k;
#pragma unroll
        for (int j = 0; j < 4; ++j) {
            const int jc = nt * 128 + wc * 64 + j * 16 + fq * 4;
            const float4 bb = *(const float4*)(p.b_four + l * 256 + jc);
            const f32x4 vp = accP[i][j], vq = accQ[i][j];
            {
                const uint2 g = *(const uint2*)(p.px + (size_t)m1 * PXW + PX_GF + jc);
                const float o0 = ((vp[0] + vq[0]) * scale + bb.x) * lo_bf(g.x), o1 = ((vp[1] + vq[1]) * scale + bb.y) * hi_bf(g.x);
                const float o2 = ((vp[2] + vq[2]) * scale + bb.z) * lo_bf(g.y), o3 = ((vp[3] + vq[3]) * scale + bb.w) * hi_bf(g.y);
                *(uint2*)(p.ycat + (size_t)m1 * LDK + 768 + jc) = make_uint2(cvtpk(o0, o1), cvtpk(o2, o3));
            }
            if (k != 0) {
                const uint2 g = *(const uint2*)(p.px + (size_t)m2 * PXW + PX_GF + jc);
                const float o0 = ((vp[0] - vq[0]) * scale + bb.x) * lo_bf(g.x), o1 = ((vp[1] - vq[1]) * scale + bb.y) * hi_bf(g.x);
                const float o2 = ((vp[2] - vq[2]) * scale + bb.z) * lo_bf(g.y), o3 = ((vp[3] - vq[3]) * scale + bb.w) * hi_bf(g.y);
                *(uint2*)(p.ycat + (size_t)m2 * LDK + 768 + jc) = make_uint2(cvtpk(o0, o1), cvtpk(o2, o3));
            }
        }
    }
}
__device__ void nyq_item(const Params& p, int l, int it) {
    const int tid = opaque_tid(), lane = tid & 63, w = tid >> 6;
    const bool lat = it < 256;
    const int q = lat ? it : it - 256, b = q >> 5, j0 = (q & 31) * 8 + w * 2;
    const int N = lat ? 2048 : 256, tok = lat ? (b * 2048 + 1024) : (NTOK + b * 256 + 128);
    const bf16_t* fb = lat ? (p.fbl + (size_t)(b * 256) * LDF) : (p.fbc + (size_t)(b * 256) * 512);
    const int fld = lat ? LDF : 512;
    const float scale = lat ? 0.022097086912079608f : 0.0625f;
    u32x4 v[2][4];
#pragma unroll
    for (int jj = 0; jj < 2; ++jj)
#pragma unroll
        for (int c = 0; c < 4; ++c) {
            const int ch = lane + 64 * c;
            v[jj][c] = (ch < (N >> 3)) ? *(const u32x4*)(fb + (size_t)(j0 + jj) * fld + ch * 8) : (u32x4){0u, 0u, 0u, 0u};
        }
    float gpre[2], bpre[2];
#pragma unroll
    for (int jj = 0; jj < 2; ++jj) { gpre[jj] = bf2f(p.px[(size_t)tok * PXW + PX_GF + j0 + jj]); bpre[jj] = p.b_four[l * 256 + j0 + jj]; }
#pragma unroll
    for (int jj = 0; jj < 2; ++jj) {
        float s = 0.f;
#pragma unroll
        for (int c = 0; c < 4; ++c)
#pragma unroll
            for (int e = 0; e < 4; ++e) s += lo_bf(v[jj][c][e]) - hi_bf(v[jj][c][e]);
#pragma unroll
        for (int o = 32; o >= 1; o >>= 1) s += __shfl_xor(s, o);
        if (lane == 0) {
            const int j = j0 + jj;
            const float o = (s * scale + bpre[jj]) * gpre[jj];
            p.ycat[(size_t)tok * LDK + 768 + j] = (bf16_t)(cvtpk(o, 0.f) & 0xffffu);
        }
    }
}

__device__ void sw_item(const Params& p, int it) {
    const int tid = opaque_tid(), lane = tid & 63, w = tid >> 6;
    const int n0 = it * 16 + w * 4;
    float wv[4][16];
#pragma unroll
    for (int c = 0; c < 4; ++c) {
        const bf16_t* wr_ = p.winT + (size_t)NINP * LDK + (size_t)(n0 + c) * LDK + lane * 16;
        const u32x4 u0 = *(const u32x4*)(wr_), u1 = *(const u32x4*)(wr_ + 8);
#pragma unroll
        for (int e = 0; e < 4; ++e) { wv[c][2 * e] = lo_bf(u0[e]); wv[c][2 * e + 1] = hi_bf(u0[e]); wv[c][8 + 2 * e] = lo_bf(u1[e]); wv[c][8 + 2 * e + 1] = hi_bf(u1[e]); }
    }
#pragma unroll 3
    for (int b = 0; b < 9; ++b) {
        const float* sh = p.mod + ((size_t)9 + b) * 3072 + lane * 16;
        float hv[16];
#pragma unroll
        for (int q = 0; q < 4; ++q) { const float4 t = *(const float4*)(sh + 4 * q); hv[4 * q] = t.x; hv[4 * q + 1] = t.y; hv[4 * q + 2] = t.z; hv[4 * q + 3] = t.w; }
        float acc[4];
#pragma unroll
        for (int c = 0; c < 4; ++c) {
            float a = 0.f;
#pragma unroll
            for (int e = 0; e < 16; ++e) a += hv[e] * wv[c][e];
#pragma unroll
            for (int o = 32; o >= 1; o >>= 1) a += __shfl_xor(a, o);
            acc[c] = a;
        }
        if (lane == 0) *(float4*)(p.sw + (size_t)b * NINP + n0) = make_float4(acc[0], acc[1], acc[2], acc[3]);
    }
}

__device__ void outproj_tile(const Params& p, int l, int mt, int nt, unsigned char* lds) {
    const int tid = opaque_tid(), lane = tid & 63, w = tid >> 6, wr = w >> 1, wc = w & 1, fr = lane & 15, fq = lane >> 4;
    f32x4 acc[4][4];
    gemm_core<true>(p.ycat + (size_t)(mt * 128) * LDK, LDK, p.woutT + (size_t)l * 1024 * LDK + (size_t)(nt * 128) * LDK, LDK, 1024, lds, acc);
    const int chunk = tid & 31, rsub = tid >> 5;
    const int n = nt * 128 + chunk * 4;
    const int m0 = mt * 128;
    const int b = (m0 < NTOK) ? (m0 >> 11) : 8;
    const float* xo; float* xn;
    if (m0 < NTOK) { xo = (l == 0 ? p.x : (const float*)p.out) + (size_t)m0 * DM + n; xn = p.out + (size_t)m0 * DM + n; }
    else { xo = p.ctx + (size_t)(m0 - NTOK) * DM + n; xn = p.x1c + (size_t)(m0 - NTOK) * DM + n; }
    const float4 g = *(const float4*)(p.mod + ((size_t)l * 9 + b) * 3072 + 2048 + n);
    float4 xv[16];
#pragma unroll
    for (int it = 0; it < 16; ++it) xv[it] = *(const float4*)(xo + (size_t)(it * 8 + rsub) * DM);
    float4 gs = make_float4(0.f, 0.f, 0.f, 0.f);
    if (l == 0) {
        const float4 g1 = *(const float4*)(p.norm_g + DM + n), s1 = *(const float4*)(p.mod + ((size_t)9 + b) * 3072 + 1024 + n);
        gs = make_float4(g1.x * (1.f + s1.x), g1.y * (1.f + s1.y), g1.z * (1.f + s1.z), g1.w * (1.f + s1.w));
    }
    float* sC = (float*)lds;
    __syncthreads();
#pragma unroll
    for (int i = 0; i < 4; ++i) {
        const int row = wr * 64 + i * 16 + fr;
#pragma unroll
        for (int j = 0; j < 4; ++j) {
            const int c = wc * 16 + j * 4 + fq;
            *(f32x4*)(sC + row * 128 + ((c ^ (row & 7)) << 2)) = acc[i][j];
        }
    }
    __syncthreads();
    if (l == 1) {
#pragma unroll
        for (int it = 0; it < 16; ++it) {
            const int row = it * 8 + rsub;
            const f32x4 v = *(const f32x4*)(sC + row * 128 + ((chunk ^ (row & 7)) << 2));
            const float4 o = make_float4(xv[it].x + g.x * v[0], xv[it].y + g.y * v[1], xv[it].z + g.z * v[2], xv[it].w + g.w * v[3]);
            xv[it] = o;
            float ss = o.x * o.x + o.y * o.y + o.z * o.z + o.w * o.w;
#pragma unroll
            for (int sh = 16; sh >= 1; sh >>= 1) ss += __shfl_xor(ss, sh);
            if (chunk == 0) atomicAdd(p.rowss2 + m0 + row, ss);
        }
        asm volatile("s_waitcnt vmcnt(0)" ::: "memory");
        __syncthreads();
        if (tid == 0) {
            unsigned* cnt = p.pcnt + mt * 16;
            __builtin_amdgcn_fence(__ATOMIC_RELEASE, "agent");
            asm volatile("s_waitcnt vmcnt(0)" ::: "memory");
            (void)__hip_atomic_fetch_add(cnt, 1u, __ATOMIC_RELAXED, __HIP_MEMORY_SCOPE_AGENT);
            unsigned sp = 0;
            while (__hip_atomic_load(cnt, __ATOMIC_RELAXED, __HIP_MEMORY_SCOPE_AGENT) < 8u) { __builtin_amdgcn_s_sleep(1); if (++sp > (1u << 22)) break; }
            __builtin_amdgcn_fence(__ATOMIC_ACQUIRE, "agent");
            asm volatile("s_waitcnt vmcnt(0)" ::: "memory");
        }
        __syncthreads();
        const float4 fg = *(const float4*)(p.final_g + n);
#pragma unroll
        for (int it = 0; it < 16; ++it) {
            const int row = it * 8 + rsub;
            const float ssum = __hip_atomic_load(p.rowss2 + m0 + row, __ATOMIC_RELAXED, __HIP_MEMORY_SCOPE_AGENT);
            const float rstd = rsqrtf(ssum * (1.f / 1024.f) + 1e-6f);
            *(float4*)(xn + (size_t)row * DM) = make_float4(xv[it].x * rstd * fg.x, xv[it].y * rstd * fg.y, xv[it].z * rstd * fg.z, xv[it].w * rstd * fg.w);
        }
        return;
    }
#pragma unroll
    for (int it = 0; it < 16; ++it) {
        const int row = it * 8 + rsub;
        const f32x4 v = *(const f32x4*)(sC + row * 128 + ((chunk ^ (row & 7)) << 2));
        const float4 o = make_float4(xv[it].x + g.x * v[0], xv[it].y + g.y * v[1], xv[it].z + g.z * v[2], xv[it].w + g.w * v[3]);
        *(float4*)(xn + (size_t)row * DM) = o;
        if (l == 0) {
            *(uint2*)(p.hx + (size_t)(m0 + row) * LDK + n) = make_uint2(cvtpk(o.x * gs.x, o.y * gs.y), cvtpk(o.z * gs.z, o.w * gs.w));
            float ss = o.x * o.x + o.y * o.y + o.z * o.z + o.w * o.w;
#pragma unroll
            for (int sh = 16; sh >= 1; sh >>= 1) ss += __shfl_xor(ss, sh);
            if (chunk == 0) atomicAdd(p.rowss + m0 + row, ss);
        }
    }
}

__device__ void attn_item(const Params& p, int l, int item, unsigned char* lds) {
    const int tid = opaque_tid(), lane = tid & 63, w = tid >> 6, r = lane & 31, hh = lane >> 5;
    int b, n, hp; bool isctx;
    if (item < 512) { b = item >> 6; n = (item >> 2) & 15; hp = item & 3; isctx = false; }
    else { const int q = item - 512; b = q >> 3; n = (q >> 2) & 1; hp = q & 3; isctx = true; }
    const int kvh = hp >> 1, h0 = hp * 2;
    const int qrow0 = isctx ? (NTOK + b * 256 + n * 128) : (b * 2048 + n * 128);
    int lo = 0, hi = 0;
    if (!isctx) { lo = (n - 1) * 128; if (lo < 0) lo = 0; hi = (n + 2) * 128; if (hi > 2048) hi = 2048; }
    const int ntiles = 4 + ((hi - lo) >> 6);
    const int qtok = qrow0 + w * 32 + r;
    const int qpos = n * 128 + w * 32 + r;
    bf16x8 qf[2][4];
#pragma unroll
    for (int hq = 0; hq < 2; ++hq) {
        const bf16_t* qp = p.px + (size_t)qtok * PXW + PX_Q + (h0 + hq) * 64 + 8 * hh;
#pragma unroll
        for (int s = 0; s < 4; ++s) qf[hq][s] = *(const bf16x8*)(qp + 16 * s);
    }
    const int lrow = tid >> 3, lchunk = (tid & 7) ^ ((lrow >> 1) & 7);
    unsigned char* la = lds + __builtin_amdgcn_readfirstlane(tid >> 6) * 1024;
    auto issue = [&](int ti) {
        const bf16_t *kb, *vb; int vld;
        if (ti < 4) { kb = p.px + (size_t)(NTOK + b * 256 + ti * 64) * PXW + PX_K + kvh * 64; vb = p.vtc + (size_t)(b * 128 + kvh * 64) * 256 + ti * 64; vld = 256; }
        else { const int pos0 = lo + (ti - 4) * 64; kb = p.px + (size_t)(b * 2048 + pos0) * PXW + PX_K + kvh * 64; vb = p.vtl + (size_t)(b * 128 + kvh * 64) * LDV + pos0; vld = LDV; }
        unsigned char* dst = la + (ti & 3) * 16384;
#pragma unroll
        for (int q = 0; q < 2; ++q) {
            __builtin_amdgcn_global_load_lds((const unsigned*)(kb + (size_t)(lrow + 32 * q) * PXW + lchunk * 8), (unsigned*)(dst + q * 4096), 16, 0, 0);
            __builtin_amdgcn_global_load_lds((const unsigned*)(vb + (size_t)(lrow + 32 * q) * vld + lchunk * 8), (unsigned*)(dst + 8192 + q * 4096), 16, 0, 0);
        }
    };
    const int fsw = (r >> 1) & 7;
    float sinkv[2], mrun[2], lsum[2];
    f32x16 O[2][2];
#pragma unroll
    for (int hq = 0; hq < 2; ++hq) {
        sinkv[hq] = p.attn_sink[l * 8 + h0 + hq] * 1.4426950408889634f; mrun[hq] = sinkv[hq]; lsum[hq] = 0.f;
#pragma unroll
        for (int e = 0; e < 16; ++e) { O[hq][0][e] = 0.f; O[hq][1][e] = 0.f; }
    }
    asm volatile("" :: "v"(qf[0][0]), "v"(qf[0][1]), "v"(qf[0][2]), "v"(qf[0][3]), "v"(qf[1][0]), "v"(qf[1][1]), "v"(qf[1][2]), "v"(qf[1][3]));
    __syncthreads();
    issue(0); issue(1); issue(2);
    const int wq0 = n * 128 + w * 32;
    for (int ti = 0; ti < ntiles; ++ti) {
        const int rem = ntiles - 1 - ti;
        if (rem >= 2) asm volatile("s_waitcnt vmcnt(8)" ::: "memory");
        else if (rem == 1) asm volatile("s_waitcnt vmcnt(4)" ::: "memory");
        else asm volatile("s_waitcnt vmcnt(0)" ::: "memory");
        __builtin_amdgcn_s_barrier();
        asm volatile("" ::: "memory");
        if (ti + 3 < ntiles) issue(ti + 3);
        const bool local = ti >= 4;
        const int pos0 = lo + (ti - 4) * 64;
        const unsigned char* kbuf = lds + (ti & 3) * 16384;
        const unsigned char* vbuf = kbuf + 8192;
#pragma unroll
        for (int kb = 0; kb < 2; ++kb) {
            const int k0 = pos0 + kb * 32;
            const int dlo = wq0 - k0 - 31, dhi = wq0 + 31 - k0;
            if (local && (dhi < -128 || dlo > 128)) continue;
            const bool partial = local && (dlo < -128 || dhi > 128);
            bf16x8 ka[4];
#pragma unroll
            for (int s = 0; s < 4; ++s) ka[s] = *(const bf16x8*)(kbuf + (kb * 32 + r) * 128 + (((2 * s + hh) ^ fsw) << 4));
            bf16x8 pf[2][2];
            f32x16 SS[2];
            __builtin_amdgcn_s_setprio(1);
#pragma unroll
            for (int hq = 0; hq < 2; ++hq) {
#pragma unroll
                for (int e = 0; e < 16; ++e) SS[hq][e] = 0.f;
#pragma unroll
                for (int s = 0; s < 4; ++s) SS[hq] = __builtin_amdgcn_mfma_f32_32x32x16_bf16(ka[s], qf[hq][s], SS[hq], 0, 0, 0);
            }
            __builtin_amdgcn_s_setprio(0);
#pragma unroll
            for (int hq = 0; hq < 2; ++hq) {
                f32x16 S = SS[hq];
                if (partial) {
#pragma unroll
                    for (int e = 0; e < 16; ++e) {
                        const int d = qpos - (k0 + (e & 3) + 8 * (e >> 2) + 4 * hh);
                        if (d > 128 || d < -128) S[e] = -1e30f;
                    }
                }
                float mx = __builtin_fmaxf(__builtin_fmaxf(S[0], S[1]), S[2]);
#pragma unroll
                for (int e = 3; e < 15; e += 2) mx = __builtin_fmaxf(__builtin_fmaxf(mx, S[e]), S[e + 1]);
                mx = __builtin_fmaxf(mx, S[15]);
                if (__any(mx > mrun[hq] + 8.f)) {
                    mx = fmaxf(mx, __shfl_xor(mx, 32));
                    const float mnew = fmaxf(mrun[hq], mx);
                    const float alpha = __builtin_amdgcn_exp2f(mrun[hq] - mnew);
                    mrun[hq] = mnew;
                    lsum[hq] *= alpha;
#pragma unroll
                    for (int e = 0; e < 16; ++e) { O[hq][0][e] *= alpha; O[hq][1][e] *= alpha; }
                }
                float ps0 = 0.f, ps1 = 0.f;
#pragma unroll
                for (int e = 0; e < 16; e += 2) {
                    const float p0 = __builtin_amdgcn_exp2f(S[e] - mrun[hq]), p1 = __builtin_amdgcn_exp2f(S[e + 1] - mrun[hq]);
                    S[e] = p0; S[e + 1] = p1; ps0 += p0; ps1 += p1;
                }
                lsum[hq] += ps0 + ps1;
#pragma unroll
                for (int s2 = 0; s2 < 2; ++s2) {
                    u32x4 pfu;
#pragma unroll
                    for (int e = 0; e < 4; ++e) pfu[e] = cvtpk(S[8 * s2 + 2 * e], S[8 * s2 + 2 * e + 1]);
                    pf[hq][s2] = __builtin_bit_cast(bf16x8, pfu);
                }
            }
#pragma unroll
            for (int s2 = 0; s2 < 2; ++s2)
#pragma unroll
                for (int db = 0; db < 2; ++db) {
                    const unsigned char* vrow = vbuf + (db * 32 + r) * 128 + 8 * hh;
                    const int c0 = 4 * kb + 2 * s2;
                    const bf16x4 v0 = *(const bf16x4*)(vrow + ((c0 ^ fsw) << 4)), v1 = *(const bf16x4*)(vrow + (((c0 + 1) ^ fsw) << 4));
                    const bf16x8 afv = __builtin_shufflevector(v0, v1, 0, 1, 2, 3, 4, 5, 6, 7);
                    __builtin_amdgcn_s_setprio(1);
                    O[0][db] = __builtin_amdgcn_mfma_f32_32x32x16_bf16(afv, pf[0][s2], O[0][db], 0, 0, 0);
                    O[1][db] = __builtin_amdgcn_mfma_f32_32x32x16_bf16(afv, pf[1][s2], O[1][db], 0, 0, 0);
                    __builtin_amdgcn_s_setprio(0);
                }
        }
    }
#pragma unroll
    for (int hq = 0; hq < 2; ++hq) {
        const int h = h0 + hq;
        float ls = lsum[hq];
        ls += __shfl_xor(ls, 32);
        ls += __builtin_amdgcn_exp2f(sinkv[hq] - mrun[hq]);
        const float inv = 1.f / ls;
#pragma unroll
        for (int db = 0; db < 2; ++db)
#pragma unroll
            for (int g = 0; g < 4; ++g) {
                const int dim = db * 32 + 8 * g + 4 * hh;
                const uint2 ga = *(const uint2*)(p.px + (size_t)qtok * PXW + PX_GA + h * 64 + dim);
                const float o0 = O[hq][db][4 * g + 0] * inv * lo_bf(ga.x), o1 = O[hq][db][4 * g + 1] * inv * hi_bf(ga.x);
                const float o2 = O[hq][db][4 * g + 2] * inv * lo_bf(ga.y), o3 = O[hq][db][4 * g + 3] * inv * hi_bf(ga.y);
                *(uint2*)(p.ycat + (size_t)qtok * LDK + h * 64 + dim) = make_uint2(cvtpk(o0, o1), cvtpk(o2, o3));
            }
    }
}

__device__ void conv_item(const Params& p, int l, int item, float* lds) {
    const int tid = opaque_tid(), lane = tid & 63, w = tid >> 6;
    int row0, len, t0;
    if (item < 512) { const int b = item >> 6; row0 = b * 2048; len = 2048; t0 = (item & 63) * 32; }
    else { const int q = item - 512, b = q >> 3; row0 = NTOK + b * 256; len = 256; t0 = (q & 7) * 32; }
    float wgt[31];
#pragma unroll
    for (int j = 0; j < 31; ++j) wgt[j] = p.conv_w[((size_t)l * 31 + j) * 256 + tid];
    const float cb = p.conv_b[l * 256 + tid];
    u32x4 av[8], gv[8];
#pragma unroll
    for (int q = 0; q < 8; ++q) {
        int id = tid + 256 * q; if (id > 62 * 32 - 1) id = 62 * 32 - 1;
        const int pp = id >> 5, c8 = (id & 31) * 8;
        int pos = t0 - 15 + pp; pos = pos < 0 ? 0 : (pos > len - 1 ? len - 1 : pos);
        const bf16_t* rp = p.px + (size_t)(row0 + pos) * PXW;
        av[q] = *(const u32x4*)(rp + PX_CA + c8); gv[q] = *(const u32x4*)(rp + PX_CB + c8);
    }
    __syncthreads();
#pragma unroll
    for (int q = 0; q < 8; ++q) {
        const int id = tid + 256 * q;
        const int pp = id >> 5, c8 = (id & 31) * 8;
        const int pos = t0 - 15 + pp;
        const float keep = (pos >= 0 && pos < len) ? 1.f : 0.f;
        float u[8];
#pragma unroll
        for (int e = 0; e < 4; ++e) { u[2 * e] = keep * lo_bf(av[q][e]) * sigm_f(lo_bf(gv[q][e])); u[2 * e + 1] = keep * hi_bf(av[q][e]) * sigm_f(hi_bf(gv[q][e])); }
        if (id < 62 * 32) {
            *(float4*)(lds + pp * 256 + c8) = make_float4(u[0], u[1], u[2], u[3]);
            *(float4*)(lds + pp * 256 + c8 + 4) = make_float4(u[4], u[5], u[6], u[7]);
        }
    }
    __syncthreads();
    float win[31];
#pragma unroll
    for (int j = 0; j < 31; ++j) win[j] = lds[j * 256 + tid];
#pragma unroll
    for (int tt = 0; tt < 32; ++tt) {
        float y0 = cb, y1 = 0.f;
#pragma unroll
        for (int j = 0; j < 30; j += 2) { y0 += wgt[j] * win[j]; y1 += wgt[j + 1] * win[j + 1]; }
        y0 += wgt[30] * win[30];
        const float nu = (tt < 31) ? lds[(tt + 31) * 256 + tid] : 0.f;
        lds[tt * 256 + tid] = y0 + y1;
#pragma unroll
        for (int j = 0; j < 30; ++j) win[j] = win[j + 1];
        win[30] = nu;
    }
    __syncthreads();
    const float4 lg = *(const float4*)(p.conv_ln_g + l * 256 + lane * 4), lb = *(const float4*)(p.conv_ln_b + l * 256 + lane * 4);
    uint2 gcv[8];
#pragma unroll
    for (int q = 0; q < 8; ++q) gcv[q] = *(const uint2*)(p.px + (size_t)(row0 + t0 + w * 8 + q) * PXW + PX_GC + lane * 4);
#pragma unroll
    for (int q = 0; q < 8; ++q) {
        const int t = w * 8 + q;
        const float4 v = *(const float4*)(lds + t * 256 + lane * 4);
        float s = v.x + v.y + v.z + v.w;
#pragma unroll
        for (int o = 32; o >= 1; o >>= 1) s += __shfl_xor(s, o);
        const float mu = s * (1.f / 256.f);
        const float d0 = v.x - mu, d1 = v.y - mu, d2 = v.z - mu, d3 = v.w - mu;
        float vs = d0 * d0 + d1 * d1 + d2 * d2 + d3 * d3;
#pragma unroll
        for (int o = 32; o >= 1; o >>= 1) vs += __shfl_xor(vs, o);
        const float rstd = rsqrtf(vs * (1.f / 256.f) + 1e-6f);
        const size_t tok = (size_t)(row0 + t0 + t);
        const uint2 gc = gcv[q];
        const float o0 = silu_f(d0 * rstd * lg.x + lb.x) * lo_bf(gc.x), o1 = silu_f(d1 * rstd * lg.y + lb.y) * hi_bf(gc.x);
        const float o2 = silu_f(d2 * rstd * lg.z + lb.z) * lo_bf(gc.y), o3 = silu_f(d3 * rstd * lg.w + lb.w) * hi_bf(gc.y);
        *(uint2*)(p.ycat + tok * LDK + 512 + lane * 4) = make_uint2(cvtpk(o0, o1), cvtpk(o2, o3));
    }
}

__device__ void final_item(const Params& p, int item) {
    const int tid = opaque_tid(), lane = tid & 63, w = tid >> 6;
    const int m0 = item * 8 + w * 2;
    float* row0 = p.out + (size_t)m0 * DM;
    float4 v[2][4];
#pragma unroll
    for (int rr = 0; rr < 2; ++rr)
#pragma unroll
        for (int i = 0; i < 4; ++i) v[rr][i] = *(const float4*)(row0 + rr * DM + i * 256 + lane * 4);
    float4 g[4];
#pragma unroll
    for (int i = 0; i < 4; ++i) g[i] = *(const float4*)(p.final_g + i * 256 + lane * 4);
#pragma unroll
    for (int rr = 0; rr < 2; ++rr) {
        float ss = 0.f;
#pragma unroll
        for (int i = 0; i < 4; ++i) ss += v[rr][i].x * v[rr][i].x + v[rr][i].y * v[rr][i].y + v[rr][i].z * v[rr][i].z + v[rr][i].w * v[rr][i].w;
#pragma unroll
        for (int o = 32; o >= 1; o >>= 1) ss += __shfl_xor(ss, o);
        const float rstd = rsqrtf(ss * (1.f / 1024.f) + 1e-6f);
#pragma unroll
        for (int i = 0; i < 4; ++i)
            *(float4*)(row0 + rr * DM + i * 256 + lane * 4) = make_float4(v[rr][i].x * rstd * g[i].x, v[rr][i].y * rstd * g[i].y, v[rr][i].z * rstd * g[i].z, v[rr][i].w * rstd * g[i].w);
    }
}

constexpr int N_PHASES = 10;
__device__ void mixer_phase(const Params& p, int l, unsigned char* lds) {
    const int G = gridDim.x, bid = blockIdx.x;
    const int NFx = l == 0 ? 18 : 16, NAx = l == 0 ? 72 : 64, NCx = l == 0 ? 72 : 64, NNx = l == 0 ? 64 : 32, NSx = l == 0 ? 22 : 0;
    const int NSM = NCx + NNx + NSx;
    const int x = bid & 7, S = G >> 3;
    for (int s = bid >> 3; s < 64; s += S) {
        const int i = s - NFx, R = 64 - NFx;
        const int nA = (s < NFx) ? 0 : ((i < NAx) ? (NAx - i + R - 1) / R : 0);
        for (int k = 0;; ++k) {
            int type, idx;
            if (s < NFx) {
                if (k == 0) { type = 0; idx = s < 16 ? x * 16 + s : 128 + x * 2 + (s - 16); }
                else if (k == 1) {
                    const int c = NSM - 1 - s;
                    const int q = c - NCx;
                    if (q < NNx) { type = 3; idx = q < 32 ? x * 32 + q : 256 + x * 32 + (q - 32); }
                    else { type = 4; idx = x * 22 + (q - NNx); }
                }
                else break;
            } else if (k < nA) {
                const int a = i + k * R;
                type = 1; idx = a < 64 ? x * 64 + a : 512 + x * 8 + (a - 64);
            } else {
                const int i0 = NAx - R, ks = k - nA;
                int c;
                if (i < i0) { if (ks > 0) break; c = i; }
                else c = i0 + (i - i0) + ks * (R - i0);
                if (c >= NSM - NFx) break;
                if (c < NCx) { type = 2; idx = c < 64 ? x * 64 + c : 512 + x * 8 + (c - 64); }
                else if (c < NCx + NNx) { const int q = c - NCx; type = 3; idx = q < 32 ? x * 32 + q : 256 + x * 32 + (q - 32); }
                else { type = 4; idx = x * 22 + (c - NCx - NNx); }
            }
            if (type == 0) fourier_tile(p, l, idx, lds);
            else if (type == 1) attn_item(p, l, idx, lds);
            else if (type == 2) conv_item(p, l, idx, (float*)lds);
            else if (type == 3) nyq_item(p, l, idx);
            else sw_item(p, idx);
        }
    }
}
DEV bool gemm_decode(int k, int nMx, int nN, int extra, int& mt, int& nt) {
    const int x = blockIdx.x & 7, S = gridDim.x >> 3, tl = (blockIdx.x >> 3) + k * S, tot = nMx * nN;
    if (tl < tot) { mt = (tl / nN) * 8 + x; nt = tl % nN; return true; }
    const int e = (tl - tot) * 8 + x;
    if (e < extra) { mt = 128 + (e >> 1); nt = (e & 1) ? 17 : 4; return true; }
    return false;
}
__device__ void run_phase(const Params& p, int ph, unsigned char* lds, int dup) {
    const int G = gridDim.x, bid = blockIdx.x;
    switch (ph) {
    case 0: phase0(p, lds); break;
    case 1:
        {
            float* tab = (float*)(lds + 57344);
            for (int i = threadIdx.x; i < 2048; i += 256) tab[i] = cospif((float)i * (1.f / 1024.f));
            __syncthreads();
        }
        {
            int kp = 0, kh = 0;
            for (int r = 0;; ++r) {
                const int ip = kp * G + bid, ih = kh * G + bid;
                const bool hp = ip < 256 + P1_PREP, hh_ = ih < 2304;
                if (!hp && !hh_) break;
                const bool do_h = hh_ && (!hp || ((r + bid + (bid >> 8)) & 1));
                if (do_h) { hx_item(p, 0, ih); ++kh; }
                else { if (ip < 256) fold_item(p, ip, (float*)lds); else phase1_prep(p, ip - 256, lds); ++kp; }
            }
        }
        break;
    case 2:
        { int mt, nt; for (int k = 0; gemm_decode(k, 18, 22, 0, mt, nt); ++k) inproj_tile(p, 0, mt, nt, lds); }
        break;
    case 3: mixer_phase(p, 0, lds); break;
    case 4:
        { int mt, nt; for (int k = 0; gemm_decode(k, 18, 8, 0, mt, nt); ++k) outproj_tile(p, 0, mt, nt, lds); }
        break;
    case 5:
        for (int it = bid; it < 2304; it += G) hx_item(p, 1, it);
        break;
    case 6:
        { int mt, nt; for (int k = 0; gemm_decode(k, 16, 22, 32, mt, nt); ++k) inproj_tile(p, 1, mt, nt, lds); }
        break;
    case 7: mixer_phase(p, 1, lds); break;
    case 8:
        { int mt, nt; for (int k = 0; gemm_decode(k, 16, 8, 0, mt, nt); ++k) outproj_tile(p, 1, mt, nt, lds); }
        break;
    case 9:
        for (int it = bid; it < 2048; it += G) final_item(p, it);
        break;
    }
}

__global__ void __launch_bounds__(256, 2) mega(Params p, int ph_lo, int ph_hi, int ph_dup) {
    __shared__ __attribute__((aligned(16))) unsigned char lds[LDS_BYTES];
#if MK_MULTI
    run_phase(p, ph_lo, lds);
#else
    XcdBarrier xb = xcd_barrier_post(p.bar);
    for (int ph = ph_lo; ph < ph_hi; ++ph) {
        if (ph == 5 || ph == 9) continue;
        const int reps = 1 + ((ph_dup >> ph) & 1);
        for (int r = 0; r < reps; ++r) {
            run_phase(p, ph, lds, ph_dup);
            if (r + 1 < reps) xcd_barrier(xb);
        }
        if (ph + 1 < ph_hi) {
            if (ph_lo < 0) cg::this_grid().sync();
            xcd_barrier(xb);
        }
    }
#endif
}

extern "C" void kernel_launch(void* const* d_in, const int* in_sizes, int n_in, void* d_out, int out_size, void* d_ws, size_t ws_size, hipStream_t stream) {
    Params p{};
    p.x = (const float*)d_in[0]; p.c = (const float*)d_in[1]; p.ctx = (const float*)d_in[2]; p.c_ctx = (const float*)d_in[3];
    p.w_ada = (const float*)d_in[4]; p.b_ada = (const float*)d_in[5]; p.norm_g = (const float*)d_in[6]; p.w_in = (const float*)d_in[7];
    p.attn_sink = (const float*)d_in[8]; p.conv_w = (const float*)d_in[9]; p.conv_b = (const float*)d_in[10]; p.conv_ln_g = (const float*)d_in[11];
    p.conv_ln_b = (const float*)d_in[12]; p.w_four = (const float*)d_in[13]; p.b_four = (const float*)d_in[14]; p.w_out = (const float*)d_in[15];
    p.final_g = (const float*)d_in[16];
    p.out = (float*)d_out;
    unsigned char* ws = (unsigned char*)d_ws;
    size_t off = 0;
    auto take = [&](size_t bytes) { unsigned char* r = ws + off; off += (bytes + 255) & ~(size_t)255; return r; };
    p.bar = (unsigned*)take(XCD_BAR_WORDS * 4);
    p.mod = (float*)take(2 * 9 * 3072 * 4);
    p.rowss = (float*)take((size_t)MTOT * 4);
    p.rowss2 = (float*)take((size_t)NTOK * 4);
    p.pcnt = (unsigned*)take((size_t)128 * 16 * 4);
    p.rope = (float*)take(96 * 16 * 2 * 4);
    p.wc = (float*)take(2 * 2 * 256 * 256 * 4);
    p.winT = (bf16_t*)take((size_t)2 * NINP * LDK * 2);
    p.woutT = (bf16_t*)take((size_t)2 * 1024 * LDK * 2);
    p.dft = (bf16_t*)take((size_t)2048 * LDF * 2);
    p.dftc = (bf16_t*)take((size_t)256 * 512 * 2);
    p.hx = (bf16_t*)take((size_t)MTOT * LDK * 2);
    p.px = (bf16_t*)take((size_t)MTOT * PXW * 2);
    p.vtl = (bf16_t*)take((size_t)8 * 128 * LDV * 2);
    p.vtc = (bf16_t*)take((size_t)8 * 128 * 256 * 2);
    p.fbl = (bf16_t*)take((size_t)8 * 256 * LDF * 2);
    p.fbc = (bf16_t*)take((size_t)8 * 256 * 512 * 2);
    p.ycat = (bf16_t*)take((size_t)MTOT * LDK * 2);
    p.x1c = (float*)take((size_t)NCTXT * 1024 * 4);
    p.fscr = (float*)take((size_t)512 * 16384 * 4);
    p.sw = (float*)take((size_t)9 * NINP * 4);
    if (off > ws_size) { fprintf(stderr, "workspace too small: need %zu have %zu\n", off, ws_size); return; }
#if MK_MULTI
    for (int ph = 0; ph < N_PHASES; ++ph) mega<<<dim3(1024), dim3(256), 0, stream>>>(p, ph, ph + 1);
#else
    static int grid_blocks = 0;
    if (!grid_blocks) {
        int dev = 0, cus = 0, per_cu = 0;
        hipGetDevice(&dev);
        hipDeviceGetAttribute(&cus, hipDeviceAttributeMultiprocessorCount, dev);
        hipOccupancyMaxActiveBlocksPerMultiprocessor(&per_cu, mega, 256, 0);
        if (per_cu > 2) per_cu = 2;
        grid_blocks = (cus * per_cu) & ~7;
        if (grid_blocks > 512) grid_blocks = 512;
        if (grid_blocks < 8) grid_blocks = 8;
    }
    (void)hipMemsetAsync(p.bar, 0, (size_t)((unsigned char*)p.pcnt - (unsigned char*)p.bar) + (size_t)128 * 16 * 4, stream);
#ifndef PH_DUP
#define PH_DUP 0
#endif
    int lo = 0, hi = 9, dup = PH_DUP;
    void* args[] = {&p, &lo, &hi, &dup};
    hipError_t e = hipLaunchCooperativeKernel((void*)mega, dim3(grid_blocks), dim3(256), args, 0, stream);
    if (e != hipSuccess) fprintf(stderr, "cooperative launch failed: %s (grid %d)\n", hipGetErrorString(e), grid_blocks);
#endif
}
```
